# Optimizing an MI355X kernel written in HIP

```python
import math
import jax, jax.numpy as jnp
from jax import lax
import numpy as np

D_MODEL = 1024
BATCH = 1
SEQ = 16384
DEPTH = 4

N_MIXERS = 2
N_SSD_LAYERS = (DEPTH + 1) // 2
N_SC_LAYERS = DEPTH // 2
RMS_EPS = 1e-5
D_FF = 2816
SSD_EXPAND = 2
SSD_D_INNER = SSD_EXPAND * D_MODEL
SSD_HEAD_DIM = 64
SSD_N_HEADS = SSD_D_INNER // SSD_HEAD_DIM
SSD_N_GROUPS = 4
SSD_HEADS_PER_GROUP = SSD_N_HEADS // SSD_N_GROUPS
SSD_D_STATE = 128
SSD_CONV_W = 4
SSD_CHUNK = 128
SSD_CONV_DIM = SSD_D_INNER + 2 * SSD_N_GROUPS * SSD_D_STATE
SSD_IN_DIM = SSD_D_INNER + SSD_CONV_DIM + SSD_N_HEADS
SSD_DT_MIN = 1e-3
SSD_DT_MAX = 1e-1
SC_CONV_W = 3

kernel_name = "hybrid_ssd_shortconv_macaron"


def rmsnorm(x, w):
    xf = x.astype(jnp.float32)
    inv = lax.rsqrt(jnp.mean(xf * xf, axis=-1, keepdims=True) + RMS_EPS)
    return (xf * inv).astype(x.dtype) * w


def swiglu(h, w_gate, w_up, w_down):
    return (jax.nn.silu(h @ w_gate) * (h @ w_up)) @ w_down


def causal_dwconv(u, w):
    k_w = w.shape[0]
    s = u.shape[1]
    upad = jnp.pad(u, ((0, 0), (k_w - 1, 0), (0, 0)))
    out = upad[:, 0:s] * w[0]
    for k in range(1, k_w):
        out = out + upad[:, k:k + s] * w[k]
    return out


def causal_decay(a_cs):
    t = a_cs.shape[-1]
    seg = a_cs[..., :, None] - a_cs[..., None, :]
    mask = jnp.tril(jnp.ones((t, t), dtype=bool))
    return jnp.exp(jnp.where(mask, seg, -jnp.inf))


def ssd_chunked(x, dt, a, bm, cm):
    b, s = x.shape[0], x.shape[1]
    nc = s // SSD_CHUNK
    G, E, P, L = SSD_N_GROUPS, SSD_HEADS_PER_GROUP, SSD_HEAD_DIM, SSD_CHUNK
    x_dt = x.astype(jnp.float32) * dt[..., None]
    xc = x_dt.reshape(b, nc, L, G, E, P)
    ac = (dt * a).reshape(b, nc, L, G, E).transpose(0, 3, 4, 1, 2)
    bc = bm.astype(jnp.float32).reshape(b, nc, L, G, SSD_D_STATE)
    cc = cm.astype(jnp.float32).reshape(b, nc, L, G, SSD_D_STATE)
    a_cs = jnp.cumsum(ac, axis=-1)
    lmat = causal_decay(a_cs)
    cb = jnp.einsum("bclgn,bcsgn->bgcls", cc, bc)
    y_diag = jnp.einsum("bgcls,bgecls,bcsgep->bclgep", cb, lmat, xc)
    decay_states = jnp.exp(a_cs[..., -1:] - a_cs)
    states = jnp.einsum("bclgn,bgecl,bclgep->bcgepn", bc, decay_states, xc)
    states = jnp.concatenate([jnp.zeros_like(states[:, :1]), states], axis=1)
    chunk_tot = jnp.pad(a_cs[..., -1], ((0, 0), (0, 0), (0, 0), (1, 0)))
    decay_chunk = causal_decay(jnp.cumsum(chunk_tot, axis=-1))
    new_states = jnp.einsum("bgezc,bcgepn->bzgepn", decay_chunk, states)
    prev_states = new_states[:, :-1]
    y_off = jnp.einsum("bclgn,bcgepn,bgecl->bclgep", cc, prev_states, jnp.exp(a_cs))
    return (y_diag + y_off).reshape(b, s, SSD_N_HEADS, P)


def ssd_mixer(h, w_in, conv_w, conv_b, dt_bias, a_log, d_skip, norm_w, w_out):
    b, s, _ = h.shape
    zxbcdt = h @ w_in
    z = zxbcdt[..., :SSD_D_INNER]
    xbc = zxbcdt[..., SSD_D_INNER:SSD_D_INNER + SSD_CONV_DIM]
    dt_raw = zxbcdt[..., SSD_D_INNER + SSD_CONV_DIM:]
    xbc = jax.nn.silu(causal_dwconv(xbc, conv_w) + conv_b)
    gn = SSD_N_GROUPS * SSD_D_STATE
    xs = xbc[..., :SSD_D_INNER].reshape(b, s, SSD_N_HEADS, SSD_HEAD_DIM)
    bm = xbc[..., SSD_D_INNER:SSD_D_INNER + gn].reshape(b, s, SSD_N_GROUPS, SSD_D_STATE)
    cm = xbc[..., SSD_D_INNER + gn:].reshape(b, s, SSD_N_GROUPS, SSD_D_STATE)
    dt = jax.nn.softplus(dt_raw.astype(jnp.float32) + dt_bias.astype(jnp.float32))
    a = -jnp.exp(a_log.astype(jnp.float32))
    y = ssd_chunked(xs, dt, a, bm, cm)
    y = y + xs.astype(jnp.float32) * d_skip.astype(jnp.float32)[:, None]
    y = y.reshape(b, s, SSD_D_INNER)
    g = y * jax.nn.silu(z.astype(jnp.float32))
    gg = g.reshape(b, s, SSD_N_GROUPS, SSD_D_INNER // SSD_N_GROUPS)
    gg = gg * lax.rsqrt(jnp.mean(gg * gg, axis=-1, keepdims=True) + RMS_EPS)
    g = gg.reshape(b, s, SSD_D_INNER).astype(h.dtype) * norm_w
    return g @ w_out


def shortconv_mixer(h, w_in, conv_w, w_out):
    bcu = h @ w_in
    bg = bcu[..., :D_MODEL]
    cg = bcu[..., D_MODEL:2 * D_MODEL]
    u = bcu[..., 2 * D_MODEL:]
    v = causal_dwconv(cg * u, conv_w)
    return (bg * v) @ w_out


def setup_inputs(seed: int = 0) -> dict:
    key = jax.random.key(seed)
    ks = jax.random.split(key, 20)
    f32 = jnp.float32
    nrm = lambda k, shape, fan_in: jax.random.normal(k, shape, f32) * (fan_in ** -0.5)
    x = jax.random.normal(ks[0], (BATCH, SEQ, D_MODEL), f32)
    norm_w = 1.0 + 0.01 * jax.random.normal(ks[1], (DEPTH, 3, D_MODEL), f32)
    ffn_w_gate = nrm(ks[2], (DEPTH, 2, D_MODEL, D_FF), D_MODEL)
    ffn_w_up = nrm(ks[3], (DEPTH, 2, D_MODEL, D_FF), D_MODEL)
    ffn_w_down = nrm(ks[4], (DEPTH, 2, D_FF, D_MODEL), D_FF)
    ssd_w_in = nrm(ks[5], (N_SSD_LAYERS, D_MODEL, SSD_IN_DIM), D_MODEL)
    ssd_conv_w = nrm(ks[6], (N_SSD_LAYERS, SSD_CONV_W, SSD_CONV_DIM), SSD_CONV_W)
    ssd_conv_b = 0.01 * jax.random.normal(ks[7], (N_SSD_LAYERS, SSD_CONV_DIM), f32)
    dt0 = jnp.exp(jax.random.uniform(ks[8], (N_SSD_LAYERS, SSD_N_HEADS), f32)
                  * (math.log(SSD_DT_MAX) - math.log(SSD_DT_MIN)) + math.log(SSD_DT_MIN))
    ssd_dt_bias = dt0 + jnp.log(-jnp.expm1(-dt0))
    ssd_a_log = jnp.log(jax.random.uniform(ks[9], (N_SSD_LAYERS, SSD_N_HEADS), f32, 1.0, 16.0))
    ssd_d = 1.0 + 0.1 * jax.random.normal(ks[10], (N_SSD_LAYERS, SSD_N_HEADS), f32)
    ssd_norm_w = 1.0 + 0.01 * jax.random.normal(ks[11], (N_SSD_LAYERS, SSD_D_INNER), f32)
    ssd_w_out = nrm(ks[12], (N_SSD_LAYERS, SSD_D_INNER, D_MODEL), SSD_D_INNER)
    sc_w_in = nrm(ks[13], (N_SC_LAYERS, D_MODEL, 3 * D_MODEL), D_MODEL)
    sc_conv_w = nrm(ks[14], (N_SC_LAYERS, SC_CONV_W, D_MODEL), SC_CONV_W)
    sc_w_out = nrm(ks[15], (N_SC_LAYERS, D_MODEL, D_MODEL), D_MODEL)
    final_norm_w = 1.0 + 0.01 * jax.random.normal(ks[16], (D_MODEL,), f32)
    return {"x": x, "norm_w": norm_w, "ffn_w_gate": ffn_w_gate, "ffn_w_up": ffn_w_up,
            "ffn_w_down": ffn_w_down, "ssd_w_in": ssd_w_in, "ssd_conv_w": ssd_conv_w,
            "ssd_conv_b": ssd_conv_b, "ssd_dt_bias": ssd_dt_bias, "ssd_a_log": ssd_a_log,
            "ssd_d": ssd_d, "ssd_norm_w": ssd_norm_w, "ssd_w_out": ssd_w_out,
            "sc_w_in": sc_w_in, "sc_conv_w": sc_conv_w, "sc_w_out": sc_w_out,
            "final_norm_w": final_norm_w}


def reference(x, norm_w, ffn_w_gate, ffn_w_up, ffn_w_down, ssd_w_in, ssd_conv_w, ssd_conv_b,
              ssd_dt_bias, ssd_a_log, ssd_d, ssd_norm_w, ssd_w_out, sc_w_in, sc_conv_w,
              sc_w_out, final_norm_w):
    for i in range(DEPTH):
        x = x + 0.5 * swiglu(rmsnorm(x, norm_w[i, 0]), ffn_w_gate[i, 0], ffn_w_up[i, 0], ffn_w_down[i, 0])
        h = rmsnorm(x, norm_w[i, 1])
        j = i // N_MIXERS
        if i % N_MIXERS == 0:
            mix = ssd_mixer(h, ssd_w_in[j], ssd_conv_w[j], ssd_conv_b[j], ssd_dt_bias[j],
                            ssd_a_log[j], ssd_d[j], ssd_norm_w[j], ssd_w_out[j])
        else:
            mix = shortconv_mixer(h, sc_w_in[j], sc_conv_w[j], sc_w_out[j])
        x = x + mix
        x = x + 0.5 * swiglu(rmsnorm(x, norm_w[i, 2]), ffn_w_gate[i, 1], ffn_w_up[i, 1], ffn_w_down[i, 1])
    return rmsnorm(x, final_norm_w)
```

```cpp
#include <hip/hip_runtime.h>
#include <hip/hip_cooperative_groups.h>
#include <cstdio>
namespace cg = cooperative_groups;
#ifndef ONE_LAUNCH
#define ONE_LAUNCH 1
#endif
namespace pg8 {
#define PG8_LAS __attribute__((address_space(3)))
typedef unsigned short bf16_t;
typedef short bf16x8 __attribute__((ext_vector_type(8)));
typedef float f32x4 __attribute__((ext_vector_type(4)));
typedef unsigned u32x4 __attribute__((ext_vector_type(4)));
constexpr int BM = 256, BK = 64, HALF = 128, HTB = HALF * BK * 2  , STAGE_BYTES = 8 * HTB, NXCD = 8, WGM = 8;

__host__ __device__ __forceinline__ int lds_byte(int r, int c) { const int st = (r >> 4) * 2 + (c >> 5), rr = r & 15, cc = c & 31, ob = rr * 64 + cc * 2; return st * 1024 + (ob ^ (((ob >> 9) & 1) << 5)); }
__host__ __device__ __forceinline__ void stage_rc(int b, int& R, int& C) { const int st = b / 1024, sb = b % 1024, swz = sb ^ (((sb >> 9) & 1) << 5); R = (st >> 1) * 16 + swz / 64; C = (st & 1) * 32 + (swz % 64) / 2; }
__host__ __device__ __forceinline__ int perm32(int rho) { const int n = rho >> 4, i = rho & 15; return 8 * (i >> 2) + 4 * n + (i & 3); }

struct Unit { int pm, pn; };
struct Gemm { const bf16_t* A; const bf16_t* Bt; int M, N, K; };
struct StaticOrder {
    int nM, nN, nwg, G, c;
    __host__ __device__ void init(int M, int N, int G_, int c_) { nM = M / BM; nN = N / BM; nwg = nM * nN; G = G_; c = c_; }
    __host__ __device__ bool next(int i, Unit& u) const {
        const long L = (long)i * G + c; if (L >= nwg) return false;
        int wgid = (int)L; { const int q = nwg / NXCD, r = nwg % NXCD, xcd = wgid % NXCD, off = wgid / NXCD; wgid = (xcd < r ? xcd * (q + 1) : r * (q + 1) + (xcd - r) * q) + off; }
        const int nig = WGM * nN, gid = wgid / nig, fm = gid * WGM, gsz = (nM - fm) < WGM ? (nM - fm) : WGM;
        u.pm = fm + ((wgid % nig) % gsz); u.pn = (wgid % nig) / gsz; return true;
    }
    __device__ __forceinline__ void a_ready(const Unit&) const {}
    __device__ __forceinline__ void done(const Unit&) const {}
};
__device__ __forceinline__ unsigned cvt_pk_bf16(float lo, float hi) { unsigned r; asm volatile("v_cvt_pk_bf16_f32 %0, %1, %2" : "=v"(r) : "v"(lo), "v"(hi)); return r; }
template <class Epi, class Sched, bool STAMP = false>
__device__ __forceinline__ void gemm_phase(PG8_LAS unsigned char* lds, const Gemm g, const Sched& S, const Epi& E, unsigned long long* stamps) {
    int tid_ = threadIdx.x; asm volatile("" : "+v"(tid_));
    const int tid = tid_, wid = __builtin_amdgcn_readfirstlane(tid >> 6), lane = tid & 63, wr = wid >> 2, wc = wid & 3, fr = lane & 15, fq = lane >> 4;
    const int K = g.K, nt = K / BK;
    int ts_lo = 0, ts_hi = 0, nts = 0; const unsigned long long rt_entry = STAMP ? (unsigned long long)wall_clock64() : 0ull;
#define PG8_STAMP() do { if (STAMP && wid == 0 && nts < 64) { const unsigned long long _c = (unsigned long long)clock64(); \
        ts_lo = (lane == nts) ? (int)(unsigned)_c : ts_lo; ts_hi = (lane == nts) ? (int)(unsigned)(_c >> 32) : ts_hi; ++nts; } } while (0)
    PG8_STAMP();
    unsigned voffA[2], voffB[2];
#pragma unroll
    for (int i = 0; i < 2; ++i) { int R, C; stage_rc(tid * 16 + i * 8192, R, C); const int Rb = Epi::PERM ? ((R & ~31) + perm32(R & 31)) : R;
        voffA[i] = (unsigned)(R * K + C) * 2u; voffB[i] = (unsigned)(Rb * K + C) * 2u; }
    const size_t kstep = (size_t)(BK * 2);
    const size_t hstep = (size_t)HALF * K * 2;
    const size_t tstep = 2 * hstep;
    const unsigned ldsw = (unsigned)wid * 1024u;
    const int aoff = lds_byte(wr * 64 + fr, fq * 8), boff = lds_byte(wc * 32 + fr, fq * 8);
#define PG8_SA(b, h) (((b) * 2 + (h)) * HTB)
#define PG8_SB(b, h) ((4 + (b) * 2 + (h)) * HTB)
#define PG8_STAGE(bufoff, gbase, voff) do { _Pragma("unroll") for (int _i = 0; _i < 2; ++_i) \
        __builtin_amdgcn_global_load_lds((const unsigned*)((const char*)(gbase) + (voff)[_i]), (PG8_LAS unsigned*)(lds + (bufoff) + ldsw + _i * 8192), 16, 0, 0); } while (0)
#define PG8_LDA(dst, b, h) do { _Pragma("unroll") for (int m = 0; m < 4; ++m) _Pragma("unroll") for (int k = 0; k < 2; ++k) dst[m][k] = *(const PG8_LAS bf16x8*)(lds + PG8_SA(b, h) + aoff + m * 2048 + k * 1024); } while (0)
#define PG8_LDB(dst, b, h) do { _Pragma("unroll") for (int n = 0; n < 2; ++n) _Pragma("unroll") for (int k = 0; k < 2; ++k) dst[n][k] = *(const PG8_LAS bf16x8*)(lds + PG8_SB(b, h) + boff + n * 2048 + k * 1024); } while (0)
#define PG8_MMA(ai, bj, At, Bt) do { __builtin_amdgcn_s_setprio(1); _Pragma("unroll") for (int m = 0; m < 4; ++m) _Pragma("unroll") for (int n = 0; n < 2; ++n) _Pragma("unroll") for (int k = 0; k < 2; ++k) \
        acc[ai][bj][m][n] = __builtin_amdgcn_mfma_f32_16x16x32_bf16(Bt[n][k], At[m][k], acc[ai][bj][m][n], 0, 0, 0); __builtin_amdgcn_s_setprio(0); } while (0)
#define PG8_WAIT_V(n) asm volatile("s_waitcnt vmcnt(" #n ")" ::: "memory")
#define PG8_WAIT_L(n) asm volatile("s_waitcnt lgkmcnt(" #n ")" ::: "memory")
#define PG8_BAR __builtin_amdgcn_s_barrier()
#define PG8_SCHED __builtin_amdgcn_sched_barrier(0)
    Unit cur, nxt; int ui = 0;
    if (!S.next(0, cur)) return;
    f32x4 acc[2][2][4][2];
#pragma unroll
    for (int a = 0; a < 2; ++a)
#pragma unroll
        for (int b = 0; b < 2; ++b)
#pragma unroll
            for (int m = 0; m < 4; ++m)
#pragma unroll
                for (int n = 0; n < 2; ++n) acc[a][b][m][n] = (f32x4){0.f, 0.f, 0.f, 0.f};
    bf16x8 At[4][2], B0[2][2], B1[2][2];
    const char* cA = (const char*)g.A + (size_t)cur.pm * tstep; const char* cB = (const char*)g.Bt + (size_t)cur.pn * tstep;
    S.a_ready(cur);
    PG8_STAGE(PG8_SB(0, 0), cB, voffB); PG8_STAGE(PG8_SA(0, 0), cA, voffA); PG8_STAGE(PG8_SB(0, 1), cB + hstep, voffB); PG8_STAGE(PG8_SA(0, 1), cA + hstep, voffA);
    if (wr == 1) PG8_BAR;
    PG8_WAIT_V(4); PG8_BAR;
    PG8_STAGE(PG8_SB(1, 0), cB + kstep, voffB); PG8_STAGE(PG8_SA(1, 0), cA + kstep, voffA); PG8_STAGE(PG8_SB(1, 1), cB + hstep + kstep, voffB);
    PG8_WAIT_V(6); PG8_BAR;
    PG8_STAMP();
    for (;;) {
        const bool has_next = S.next(ui + 1, nxt);
        const char* nA = has_next ? (const char*)g.A + (size_t)nxt.pm * tstep : cA; const char* nB = has_next ? (const char*)g.Bt + (size_t)nxt.pn * tstep : cB;
        for (int t = 0; t < nt; t += 2) {
            const bool last = (t == nt - 2);
            const char* a1 = cA + (size_t)(t + 1) * kstep;
            const char* a2 = last ? nA : cA + (size_t)(t + 2) * kstep; const char* b2 = last ? nB : cB + (size_t)(t + 2) * kstep;
            const char* a3 = a2 + kstep; const char* b3 = b2 + kstep;
            if (last && has_next) S.a_ready(nxt);
            PG8_LDB(B0, 0, 0); PG8_SCHED; PG8_LDA(At, 0, 0); PG8_STAGE(PG8_SA(1, 1), a1 + hstep, voffA);
            PG8_WAIT_L(8); PG8_BAR; PG8_WAIT_L(0); PG8_MMA(0, 0, At, B0); PG8_BAR; PG8_SCHED;
            PG8_LDB(B1, 0, 1); PG8_STAGE(PG8_SB(0, 0), b2, voffB);
            PG8_BAR; PG8_WAIT_L(0); PG8_MMA(0, 1, At, B1); PG8_BAR;
            PG8_LDA(At, 0, 1); PG8_STAGE(PG8_SA(0, 0), a2, voffA);
            PG8_BAR; PG8_WAIT_L(0); PG8_MMA(1, 0, At, B0); PG8_BAR; PG8_SCHED;
            PG8_STAGE(PG8_SB(0, 1), b2 + hstep, voffB);
            PG8_WAIT_V(6); PG8_BAR; PG8_MMA(1, 1, At, B1); PG8_BAR;
            PG8_LDB(B0, 1, 0); PG8_SCHED; PG8_LDA(At, 1, 0); PG8_STAGE(PG8_SA(0, 1), a2 + hstep, voffA);
            PG8_WAIT_L(8); PG8_BAR; PG8_WAIT_L(0); PG8_MMA(0, 0, At, B0); PG8_BAR; PG8_SCHED;
            PG8_LDB(B1, 1, 1); PG8_STAGE(PG8_SB(1, 0), b3, voffB);
            PG8_BAR; PG8_WAIT_L(0); PG8_MMA(0, 1, At, B1); PG8_BAR;
            PG8_LDA(At, 1, 1); PG8_STAGE(PG8_SA(1, 0), a3, voffA);
            PG8_BAR; PG8_WAIT_L(0); PG8_MMA(1, 0, At, B0); PG8_BAR; PG8_SCHED;
            PG8_STAGE(PG8_SB(1, 1), b3 + hstep, voffB);
            PG8_WAIT_V(6); PG8_BAR; PG8_MMA(1, 1, At, B1); PG8_BAR;
        }
        PG8_STAMP();
        if constexpr (!Epi::AFTER_DRAIN) { E(acc, cur, wr, wc, fr, fq); S.done(cur); }
        PG8_STAMP();
        if (!has_next) break;
#pragma unroll
        for (int a = 0; a < 2; ++a)
#pragma unroll
            for (int b = 0; b < 2; ++b)
#pragma unroll
                for (int m = 0; m < 4; ++m)
#pragma unroll
                    for (int n = 0; n < 2; ++n) acc[a][b][m][n] = (f32x4){0.f, 0.f, 0.f, 0.f};
        cur = nxt; cA = nA; cB = nB; ++ui;
    }
    PG8_WAIT_V(0);
    if (wr == 0) PG8_BAR;
    PG8_BAR;
    if constexpr (Epi::AFTER_DRAIN) { E.fused(acc, cur, wr, wc, fr, fq, lds, wid, lane); S.done(cur); }
    PG8_STAMP();
    if (STAMP && wid == 0) { stamps[lane] = lane < nts ? (((unsigned long long)(unsigned)ts_hi << 32) | (unsigned)ts_lo) : 0ull;
        if (lane == 62) stamps[62] = rt_entry; if (lane == 63) stamps[63] = (unsigned long long)wall_clock64(); }
#undef PG8_STAMP
#undef PG8_SA
#undef PG8_SB
#undef PG8_STAGE
#undef PG8_LDA
#undef PG8_LDB
#undef PG8_MMA
#undef PG8_WAIT_V
#undef PG8_WAIT_L
#undef PG8_BAR
#undef PG8_SCHED
}
}
#define LAS __attribute__((address_space(3)))
using pg8::bf16_t; using pg8::f32x4; using pg8::u32x4; using pg8::cvt_pk_bf16;
constexpr int S_ = 16384, D_ = 1024, FF_ = 2816, DI_ = 2048, NH_ = 32, CONVD_ = 3072, INP_ = 5376, INSRC_ = 5152;
constexpr float EPS_ = 1e-5f;
constexpr int LDS_BYTES = 131072;
constexpr int NPH = 41;

constexpr size_t SZ_GU = (size_t)2 * FF_ * D_ * 2, SZ_D = (size_t)D_ * FF_ * 2, SZ_MIN = (size_t)INP_ * D_ * 2, SZ_MOUT = (size_t)D_ * DI_ * 2;
constexpr size_t WS_GU1 = 0, WS_D1 = WS_GU1 + SZ_GU, WS_GU2 = WS_D1 + SZ_D, WS_D2 = WS_GU2 + SZ_GU, WS_MIN = WS_D2 + SZ_D, WS_MOUT = WS_MIN + SZ_MIN;
constexpr size_t WS_XB = WS_MOUT + SZ_MOUT;
constexpr size_t WS_SS = WS_XB + (size_t)S_ * D_ * 2;
constexpr size_t WS_DT = WS_SS + (size_t)S_ * 16 * 4;
constexpr size_t WS_R1 = WS_DT + (size_t)S_ * 32 * 4;
constexpr size_t WS_R2 = WS_R1 + (size_t)S_ * FF_ * 2;
constexpr size_t WS_R3 = WS_R2 + (size_t)S_ * CONVD_ * 2;
constexpr size_t WS_END = WS_R3 + (size_t)S_ * CONVD_ * 2;

struct Params {
    const float *x, *norm_w, *wg, *wu, *wd, *ssd_w_in, *ssd_conv_w, *ssd_conv_b, *ssd_dt_bias, *ssd_a_log, *ssd_d, *ssd_norm_w, *ssd_w_out, *sc_w_in, *sc_conv_w, *sc_w_out, *final_w;
    float* out; unsigned char* ws; int ph_lo, ph_hi;
};

__device__ __forceinline__ float bf2f(unsigned short b) { return __uint_as_float(((unsigned)b) << 16); }
__device__ __forceinline__ float bflo(unsigned w) { return __uint_as_float(w << 16); }
__device__ __forceinline__ float bfhi(unsigned w) { return __uint_as_float(w & 0xffff0000u); }
__device__ __forceinline__ unsigned short f2bf(float f) { unsigned u = __float_as_uint(f); u += 0x7FFFu + ((u >> 16) & 1u); return (unsigned short)(u >> 16); }
__device__ __forceinline__ float wave_sum(float v) {
#pragma unroll
    for (int o = 1; o < 64; o <<= 1) v += __shfl_xor(v, o);
    return v;
}
__device__ __forceinline__ float silu_f(float v) { return v / (1.0f + __expf(-v)); }
__device__ __forceinline__ float row_rs(const float* ss, int row) {
    const f32x4* q = (const f32x4*)(ss + (size_t)row * 16);
    const f32x4 a = q[0], b = q[1], c = q[2], d = q[3];
    const float s = ((a.x + a.y) + (a.z + a.w)) + ((b.x + b.y) + (b.z + b.w)) + ((c.x + c.y) + (c.z + c.w)) + ((d.x + d.y) + (d.z + d.w));
    return rsqrtf(s * (1.0f / D_) + EPS_);
}

#ifdef FORCE_MODE
#define SETMODE(v)
#else
#define SETMODE(v) E.mode = v
#endif
struct EpiAll {
    static constexpr bool PERM = true, AFTER_DRAIN = false;
#ifdef FORCE_MODE
    static constexpr int mode = FORCE_MODE; int mode_unused;
#else
    int mode;
#endif
    bf16_t* o0; int ld0, nt0; bf16_t* o1; int ld1, dt_tile;
    float* x; float* ss; float* dt; const float* dt_bias; float scale;
    __device__ __forceinline__ void row_scales(int row0, int fq, float (&rs)[8]) const {
#pragma unroll
        for (int i = 0; i < 8; ++i) { const f32x4 a = *(const f32x4*)(ss + (size_t)(row0 + (i >> 2) * 128 + (i & 3) * 16) * 16 + 4 * fq); rs[i] = (a.x + a.y) + (a.z + a.w); }
#pragma unroll
        for (int i = 0; i < 8; ++i) { float s = rs[i]; s += __shfl_xor(s, 16); s += __shfl_xor(s, 32); rs[i] = rsqrtf(s * (1.0f / D_) + EPS_); }
    }
    __device__ __forceinline__ void operator()(const f32x4 (&acc)[2][2][4][2], const pg8::Unit& u, int wr, int wc, int fr, int fq) const {
        const int row0 = u.pm * 256 + wr * 64 + fr;
        if (mode == 1) {
            const int col0 = u.pn * 256 + wc * 32 + 8 * fq;
#pragma unroll
            for (int ai = 0; ai < 2; ++ai)
#pragma unroll
                for (int m = 0; m < 4; ++m) {
                    const int row = row0 + ai * 128 + m * 16; float q = 0.f;
#pragma unroll
                    for (int bj = 0; bj < 2; ++bj) {
                        float* xp = x + (size_t)row * D_ + col0 + bj * 128;
                        f32x4 a = *(const f32x4*)xp, b = *(const f32x4*)(xp + 4);
                        a = a + acc[ai][bj][m][0] * scale; b = b + acc[ai][bj][m][1] * scale;
                        q += (a.x * a.x + a.y * a.y) + (a.z * a.z + a.w * a.w) + (b.x * b.x + b.y * b.y) + (b.z * b.z + b.w * b.w);
                        *(f32x4*)xp = a; *(f32x4*)(xp + 4) = b;
                        u32x4 w; w.x = cvt_pk_bf16(a.x, a.y); w.y = cvt_pk_bf16(a.z, a.w); w.z = cvt_pk_bf16(b.x, b.y); w.w = cvt_pk_bf16(b.z, b.w);
                        *(u32x4*)(o0 + (size_t)row * D_ + col0 + bj * 128) = w; }
                    q += __shfl_xor(q, 16); q += __shfl_xor(q, 32);
                    if (fq == 0) ss[(size_t)row * 16 + u.pn * 4 + wc] = q; }
            return;
        }
        float rs[8]; row_scales(row0, fq, rs);
        if (mode == 0) {
            const int col0 = u.pn * 128 + wc * 32 + 8 * fq;
#pragma unroll
            for (int ai = 0; ai < 2; ++ai)
#pragma unroll
                for (int m = 0; m < 4; ++m) {
                    const int row = row0 + ai * 128 + m * 16; const float r = rs[ai * 4 + m];
                    float o[8];
#pragma unroll
                    for (int n = 0; n < 2; ++n)
#pragma unroll
                        for (int j = 0; j < 4; ++j) { const float g = acc[ai][0][m][n][j] * r, v = acc[ai][1][m][n][j] * r; o[n * 4 + j] = silu_f(g) * v; }
                    u32x4 w; w.x = cvt_pk_bf16(o[0], o[1]); w.y = cvt_pk_bf16(o[2], o[3]); w.z = cvt_pk_bf16(o[4], o[5]); w.w = cvt_pk_bf16(o[6], o[7]);
                    *(u32x4*)(o0 + (size_t)row * ld0 + col0) = w; }
        } else if (u.pn != dt_tile) {
            bf16_t* base; int ld, colt;
            if (u.pn < nt0) { base = o0; ld = ld0; colt = u.pn * 256; } else { base = o1; ld = ld1; colt = (u.pn - nt0) * 256; }
            const int col0 = colt + wc * 32 + 8 * fq;
#pragma unroll
            for (int ai = 0; ai < 2; ++ai)
#pragma unroll
                for (int m = 0; m < 4; ++m) {
                    const int row = row0 + ai * 128 + m * 16; const float r = rs[ai * 4 + m];
#pragma unroll
                    for (int bj = 0; bj < 2; ++bj) {
                        const f32x4 a = acc[ai][bj][m][0] * r, b = acc[ai][bj][m][1] * r;
                        u32x4 w; w.x = cvt_pk_bf16(a.x, a.y); w.y = cvt_pk_bf16(a.z, a.w); w.z = cvt_pk_bf16(b.x, b.y); w.w = cvt_pk_bf16(b.z, b.w);
                        *(u32x4*)(base + (size_t)row * ld + col0 + bj * 128) = w; } }
        } else if (wc == 0) {
            const f32x4 b0 = *(const f32x4*)(dt_bias + 8 * fq), b1 = *(const f32x4*)(dt_bias + 8 * fq + 4);
#pragma unroll
            for (int ai = 0; ai < 2; ++ai)
#pragma unroll
                for (int m = 0; m < 4; ++m) {
                    const int row = row0 + ai * 128 + m * 16; const float r = rs[ai * 4 + m];
                    f32x4 a = acc[ai][0][m][0] * r + b0, b = acc[ai][0][m][1] * r + b1;
#pragma unroll
                    for (int j = 0; j < 4; ++j) { a[j] = fmaxf(a[j], 0.f) + log1pf(__expf(-fabsf(a[j]))); b[j] = fmaxf(b[j], 0.f) + log1pf(__expf(-fabsf(b[j]))); }
                    float* o = dt + (size_t)row * 32 + 8 * fq; *(f32x4*)o = a; *(f32x4*)(o + 4) = b; }
        }
    }
};

template <class Epi> __device__ __forceinline__ void run_gemm(LAS unsigned char* lds, const bf16_t* A, const bf16_t* Bt, int N, int K, const Epi& E) {
    pg8::Gemm g; g.A = A; g.Bt = Bt; g.M = S_; g.N = N; g.K = K;
    pg8::StaticOrder S; S.init(S_, N, (int)gridDim.x, (int)blockIdx.x);
    pg8::gemm_phase<Epi, pg8::StaticOrder, false>(lds, g, S, E, nullptr);
}

__device__ __forceinline__ int tid_opaque() { int t = threadIdx.x; asm volatile("" : "+v"(t)); return t; }
__device__ __forceinline__ int bid_opaque() { int b = blockIdx.x; asm volatile("" : "+s"(b)); return b; }
__device__ __forceinline__ void tr_item(const float* W, int ldw, int k0, int scol0, const float* scale, bf16_t* WT, int K, int drow0, LAS float* scr, int lane) {
#pragma unroll 8
    for (int i = 0; i < 32; ++i) { const int kk = 2 * i + (lane >> 5); float v = W[(size_t)(k0 + kk) * ldw + scol0 + (lane & 31)]; if (scale) v *= scale[k0 + kk]; scr[kk * 33 + (lane & 31)] = v; }
    asm volatile("s_waitcnt lgkmcnt(0)" ::: "memory");
    const int c = lane & 7;
#pragma unroll
    for (int j = 0; j < 4; ++j) { const int n = (lane >> 3) + 8 * j; const LAS float* s = scr + (8 * c) * 33 + n;
        u32x4 o; o.x = cvt_pk_bf16(s[0 * 33], s[1 * 33]); o.y = cvt_pk_bf16(s[2 * 33], s[3 * 33]); o.z = cvt_pk_bf16(s[4 * 33], s[5 * 33]); o.w = cvt_pk_bf16(s[6 * 33], s[7 * 33]);
        *(u32x4*)(WT + (size_t)(drow0 + n) * K + k0 + 8 * c) = o; }
    asm volatile("s_waitcnt lgkmcnt(0)" ::: "memory");
}

__device__ __forceinline__ void prep_phase(const Params& p, int layer, LAS unsigned char* lds) {
    const int lane = tid_opaque() & 63, wave = tid_opaque() >> 6;
    LAS float* scr = (LAS float*)(lds + wave * 8448);
    const int gw = bid_opaque() * 8 + wave, NGW = gridDim.x * 8;
    const bool ssd = !(layer & 1); const int j = layer >> 1;
    const float* nw = p.norm_w + (size_t)layer * 3 * D_;
    constexpr int I_GU = (D_ / 64) * (FF_ / 32), I_D = (FF_ / 64) * (D_ / 32);
    const int nbin = ssd ? INSRC_ / 32 : CONVD_ / 32, I_MIN = (D_ / 64) * nbin, kout = ssd ? DI_ : D_, I_MOUT = (kout / 64) * (D_ / 32);
    const int total = 4 * I_GU + 2 * I_D + I_MIN + I_MOUT;
    for (int it = gw; it < total; it += NGW) {
        int r = it;
        if (r < 4 * I_GU) { const int which = r / I_GU; r -= which * I_GU; const int f = which >> 1, s = which & 1;
            const float* W = (s ? p.wu : p.wg) + (size_t)(layer * 2 + f) * D_ * FF_;
            const int kb = r / (FF_ / 32), nb = r - kb * (FF_ / 32), h0 = nb * 32, drow0 = 256 * (h0 >> 7) + 128 * s + (h0 & 127);
            tr_item(W, FF_, kb * 64, h0, nw + (f ? 2 * D_ : 0), (bf16_t*)(p.ws + (f ? WS_GU2 : WS_GU1)), D_, drow0, scr, lane); continue; }
        r -= 4 * I_GU;
        if (r < 2 * I_D) { const int f = r / I_D; r -= f * I_D;
            const float* W = p.wd + (size_t)(layer * 2 + f) * FF_ * D_;
            const int kb = r / (D_ / 32), nb = r - kb * (D_ / 32);
            tr_item(W, D_, kb * 64, nb * 32, nullptr, (bf16_t*)(p.ws + (f ? WS_D2 : WS_D1)), FF_, nb * 32, scr, lane); continue; }
        r -= 2 * I_D;
        if (r < I_MIN) { const int kb = r / nbin, nb = r - kb * nbin;
            const float* W = ssd ? p.ssd_w_in + (size_t)j * D_ * INSRC_ : p.sc_w_in + (size_t)j * D_ * CONVD_;
            tr_item(W, ssd ? INSRC_ : CONVD_, kb * 64, nb * 32, nw + D_, (bf16_t*)(p.ws + WS_MIN), D_, nb * 32, scr, lane); continue; }
        r -= I_MIN;
        { const int kb = r / (D_ / 32), nb = r - kb * (D_ / 32);
            const float* W = ssd ? p.ssd_w_out + (size_t)j * DI_ * D_ : p.sc_w_out + (size_t)j * D_ * D_;
            tr_item(W, D_, kb * 64, nb * 32, nullptr, (bf16_t*)(p.ws + WS_MOUT), kout, nb * 32, scr, lane); }
    }
    if (layer == 0) {
        bf16_t* xb = (bf16_t*)(p.ws + WS_XB); float* ss = (float*)(p.ws + WS_SS);
        for (int row = gw; row < S_; row += NGW) {
            const f32x4* xr = (const f32x4*)(p.x + (size_t)row * D_) + lane; f32x4* orow = (f32x4*)(p.out + (size_t)row * D_) + lane;
            unsigned long long* o8 = (unsigned long long*)(xb + (size_t)row * D_) + lane; float s = 0.f;
#pragma unroll
            for (int q = 0; q < 4; ++q) { const f32x4 v = xr[64 * q]; s += (v.x * v.x + v.y * v.y) + (v.z * v.z + v.w * v.w); orow[64 * q] = v;
                o8[64 * q] = (unsigned long long)cvt_pk_bf16(v.x, v.y) | ((unsigned long long)cvt_pk_bf16(v.z, v.w) << 32); }
            s = wave_sum(s);
            if (lane < 16) ss[(size_t)row * 16 + lane] = lane == 0 ? s : 0.f;
        }
    }
}

__device__ __forceinline__ void unpack8(const u32x4 w, float (&f)[8]) { f[0] = bflo(w.x); f[1] = bfhi(w.x); f[2] = bflo(w.y); f[3] = bfhi(w.y); f[4] = bflo(w.z); f[5] = bfhi(w.z); f[6] = bflo(w.w); f[7] = bfhi(w.w); }
__device__ __forceinline__ u32x4 pack8(const float (&f)[8]) { u32x4 w; w.x = cvt_pk_bf16(f[0], f[1]); w.y = cvt_pk_bf16(f[2], f[3]); w.z = cvt_pk_bf16(f[4], f[5]); w.w = cvt_pk_bf16(f[6], f[7]); return w; }

__device__ __forceinline__ void sc_conv_phase(const Params& p, int j) {
    const bf16_t* bcu = (const bf16_t*)(p.ws + WS_R2); bf16_t* vo = (bf16_t*)(p.ws + WS_R1); const float* cw = p.sc_conv_w + (size_t)j * 3 * D_;
    const int nthr = gridDim.x * 512;
    for (int idx = bid_opaque() * 512 + tid_opaque(); idx < S_ * 128; idx += nthr) {
        const int t = idx >> 7, c = (idx & 127) * 8; float a[8] = {0.f, 0.f, 0.f, 0.f, 0.f, 0.f, 0.f, 0.f};
#pragma unroll
        for (int k = 0; k < 3; ++k) { const int tt = t - 2 + k;
            if (tt >= 0) { float cgv[8], uv[8]; unpack8(*(const u32x4*)(bcu + (size_t)tt * CONVD_ + D_ + c), cgv); unpack8(*(const u32x4*)(bcu + (size_t)tt * CONVD_ + 2 * D_ + c), uv);
                const f32x4 w0 = *(const f32x4*)(cw + k * D_ + c), w1 = *(const f32x4*)(cw + k * D_ + c + 4);
#pragma unroll
                for (int e = 0; e < 4; ++e) { a[e] += w0[e] * (cgv[e] * uv[e]); a[4 + e] += w1[e] * (cgv[4 + e] * uv[4 + e]); } } }
        float bg[8]; unpack8(*(const u32x4*)(bcu + (size_t)t * CONVD_ + c), bg);
#pragma unroll
        for (int e = 0; e < 8; ++e) a[e] *= bg[e];
        *(u32x4*)(vo + (size_t)t * D_ + c) = pack8(a);
    }
}
__device__ __forceinline__ void ssd_conv_phase(const Params& p, int j) {
    const bf16_t* raw = (const bf16_t*)(p.ws + WS_R2); bf16_t* xo = (bf16_t*)(p.ws + WS_R3);
    const float* cw = p.ssd_conv_w + (size_t)j * 4 * CONVD_; const float* cb = p.ssd_conv_b + (size_t)j * CONVD_;
    const int nthr = gridDim.x * 512;
    for (int idx = bid_opaque() * 512 + tid_opaque(); idx < S_ * 384; idx += nthr) {
        const int t = idx / 384, c = (idx - t * 384) * 8; float a[8];
        { const f32x4 b0 = *(const f32x4*)(cb + c), b1 = *(const f32x4*)(cb + c + 4);
#pragma unroll
          for (int e = 0; e < 4; ++e) { a[e] = b0[e]; a[4 + e] = b1[e]; } }
#pragma unroll
        for (int k = 0; k < 4; ++k) { const int tt = t - 3 + k;
            if (tt >= 0) { float v[8]; unpack8(*(const u32x4*)(raw + (size_t)tt * CONVD_ + c), v);
                const f32x4 w0 = *(const f32x4*)(cw + k * CONVD_ + c), w1 = *(const f32x4*)(cw + k * CONVD_ + c + 4);
#pragma unroll
                for (int e = 0; e < 4; ++e) { a[e] += w0[e] * v[e]; a[4 + e] += w1[e] * v[4 + e]; } } }
#pragma unroll
        for (int e = 0; e < 8; ++e) a[e] = silu_f(a[e]);
        *(u32x4*)(xo + (size_t)t * CONVD_ + c) = pack8(a);
    }
}
__device__ __forceinline__ void ssd_scan_naive_phase(const Params& p, int j) {
    const bf16_t* xc = (const bf16_t*)(p.ws + WS_R3); const float* dt = (const float*)(p.ws + WS_DT); bf16_t* yb = (bf16_t*)(p.ws + WS_R2);
    const int lane = tid_opaque() & 63, wave = tid_opaque() >> 6;
    for (int hp = bid_opaque() * 8 + wave; hp < NH_ * 64; hp += gridDim.x * 8) {
        const int h = hp >> 6, pp = hp & 63, g = h >> 3;
        const float a = -__expf(p.ssd_a_log[j * NH_ + h]), Dh = p.ssd_d[j * NH_ + h];
        float h0 = 0.f, h1 = 0.f;
#pragma unroll 8
        for (int t = 0; t < S_; ++t) {
            const bf16_t* row = xc + (size_t)t * CONVD_;
            const float xt = bf2f(row[h * 64 + pp]), dtt = dt[(size_t)t * 32 + h];
            const unsigned b2 = *(const unsigned*)(row + DI_ + g * 128 + 2 * lane), c2 = *(const unsigned*)(row + DI_ + 512 + g * 128 + 2 * lane);
            const float dA = __expf(dtt * a), dtx = dtt * xt;
            h0 = dA * h0 + dtx * bflo(b2); h1 = dA * h1 + dtx * bfhi(b2);
            const float y = wave_sum(bflo(c2) * h0 + bfhi(c2) * h1) + Dh * xt;
            if (lane == 0) yb[(size_t)t * DI_ + h * 64 + pp] = f2bf(y);
        }
    }
}
__device__ __forceinline__ void ssd_gate_phase(const Params& p, int j) {
    const bf16_t* yb = (const bf16_t*)(p.ws + WS_R2); bf16_t* zg = (bf16_t*)(p.ws + WS_R1); const float* nw = p.ssd_norm_w + (size_t)j * DI_;
    const int lane = tid_opaque() & 63, wave = tid_opaque() >> 6;
    for (int idx = bid_opaque() * 8 + wave; idx < S_ * 4; idx += gridDim.x * 8) {
        const int t = idx >> 2, g = idx & 3, c = g * 512 + lane * 8;
        float y[8], z[8]; unpack8(*(const u32x4*)(yb + (size_t)t * DI_ + c), y); unpack8(*(const u32x4*)(zg + (size_t)t * DI_ + c), z);
        float q = 0.f;
#pragma unroll
        for (int e = 0; e < 8; ++e) { y[e] *= silu_f(z[e]); q += y[e] * y[e]; }
        const float rs = rsqrtf(wave_sum(q) * (1.0f / 512.f) + EPS_);
        const f32x4 w0 = *(const f32x4*)(nw + c), w1 = *(const f32x4*)(nw + c + 4);
#pragma unroll
        for (int e = 0; e < 4; ++e) { y[e] *= rs * w0[e]; y[4 + e] *= rs * w1[e]; }
        *(u32x4*)(zg + (size_t)t * DI_ + c) = pack8(y);
    }
}
__device__ __forceinline__ void final_phase(const Params& p) {
    const int lane = tid_opaque() & 63, wave = tid_opaque() >> 6;
    for (int row = bid_opaque() * 8 + wave; row < S_; row += gridDim.x * 8) {
        f32x4* xr = (f32x4*)(p.out + (size_t)row * D_) + lane; const f32x4* wr = (const f32x4*)p.final_w + lane;
        f32x4 v[4]; float s = 0.f;
#pragma unroll
        for (int q = 0; q < 4; ++q) { v[q] = xr[64 * q]; s += (v[q].x * v[q].x + v[q].y * v[q].y) + (v[q].z * v[q].z + v[q].w * v[q].w); }
        const float rs = rsqrtf(wave_sum(s) * (1.0f / D_) + EPS_);
#pragma unroll
        for (int q = 0; q < 4; ++q) xr[64 * q] = v[q] * rs * wr[64 * q];
    }
}

__host__ __device__ inline bool phase_active(int ph) { if (ph >= 40) return ph == 40; const int layer = ph / 10, k = ph % 10; return !((layer & 1) && (k == 5 || k == 6)); }

__device__ __forceinline__ void run_phase(const Params& p, int ph, LAS unsigned char* lds) {
    if (ph == 40) { final_phase(p); return; }
    const int layer = ph / 10, k = ph - layer * 10, j = layer >> 1; const bool ssd = !(layer & 1);
    bf16_t* xb = (bf16_t*)(p.ws + WS_XB); float* ss = (float*)(p.ws + WS_SS);
#ifdef PHASE_ONLY
    const int kk = PHASE_ONLY;
#else
    const int kk = k;
#endif
    EpiAll E{}; E.ss = ss; E.x = p.out; E.dt = (float*)(p.ws + WS_DT); E.dt_bias = p.ssd_dt_bias + j * NH_; E.dt_tile = -1; E.scale = 1.0f;
    const bf16_t* A = xb; const bf16_t* Bt = nullptr; int N = 0, K = D_; bool gemm = true;
    switch (kk) {
    case 1: case 8: SETMODE(0); E.o0 = (bf16_t*)(p.ws + WS_R1); E.ld0 = FF_; Bt = (const bf16_t*)(p.ws + (kk == 1 ? WS_GU1 : WS_GU2)); N = 2 * FF_; break;
    case 2: case 9: SETMODE(1); E.o0 = xb; E.scale = 0.5f; A = (const bf16_t*)(p.ws + WS_R1); Bt = (const bf16_t*)(p.ws + (kk == 2 ? WS_D1 : WS_D2)); N = D_; K = FF_; break;
    case 3: SETMODE(2); Bt = (const bf16_t*)(p.ws + WS_MIN);
            if (ssd) { E.o0 = (bf16_t*)(p.ws + WS_R1); E.ld0 = DI_; E.nt0 = 8; E.o1 = (bf16_t*)(p.ws + WS_R2); E.ld1 = CONVD_; E.dt_tile = 20; N = INP_; }
            else { E.o0 = (bf16_t*)(p.ws + WS_R2); E.ld0 = CONVD_; E.nt0 = 12; E.o1 = E.o0; E.ld1 = CONVD_; N = CONVD_; } break;
    case 7: SETMODE(1); E.o0 = xb; A = (const bf16_t*)(p.ws + WS_R1); Bt = (const bf16_t*)(p.ws + WS_MOUT); N = D_; K = ssd ? DI_ : D_; break;
    default: gemm = false; break;
    }
    if (gemm) { run_gemm(lds, A, Bt, N, K, E); return; }
    switch (kk) {
    case 0: prep_phase(p, layer, lds); break;
    case 4: if (ssd) ssd_conv_phase(p, j); else sc_conv_phase(p, j); break;
    case 5: if (ssd) ssd_scan_naive_phase(p, j); break;
    case 6: if (ssd) ssd_gate_phase(p, j); break;
    }
}

__global__ __launch_bounds__(512, 2) void mega(Params p) {
    extern __shared__ __attribute__((aligned(16))) unsigned char shm[];
    LAS unsigned char* lds = (LAS unsigned char*)shm;
    cg::grid_group grid = cg::this_grid();
    for (int ph = p.ph_lo; ph < p.ph_hi; ++ph) {
        if (!phase_active(ph)) continue;
        run_phase(p, ph, lds);
        if (ph + 1 < p.ph_hi) { __syncthreads(); grid.sync(); }
    }
}

extern "C" void kernel_launch(void* const* d_in, const int* in_sizes, int n_in, void* d_out, int out_size, void* d_ws, size_t ws_size, hipStream_t stream) {
    static int grid = 0;
    if (grid == 0) {
        int dev = 0, cus = 0, per_cu = 0;
        hipGetDevice(&dev); hipDeviceGetAttribute(&cus, hipDeviceAttributeMultiprocessorCount, dev);
        hipFuncSetAttribute((const void*)mega, hipFuncAttributeMaxDynamicSharedMemorySize, LDS_BYTES);
        hipOccupancyMaxActiveBlocksPerMultiprocessor(&per_cu, (const void*)mega, 512, LDS_BYTES);
        if (per_cu < 1) per_cu = 1;
        grid = cus * per_cu;
        if (ws_size < WS_END) fprintf(stderr, "kernel_launch: workspace too small: %zu < %zu\n", ws_size, (size_t)WS_END);
        (void)hipGetLastError();
    }
    Params p{};
    p.x = (const float*)d_in[0]; p.norm_w = (const float*)d_in[1]; p.wg = (const float*)d_in[2]; p.wu = (const float*)d_in[3]; p.wd = (const float*)d_in[4];
    p.ssd_w_in = (const float*)d_in[5]; p.ssd_conv_w = (const float*)d_in[6]; p.ssd_conv_b = (const float*)d_in[7]; p.ssd_dt_bias = (const float*)d_in[8];
    p.ssd_a_log = (const float*)d_in[9]; p.ssd_d = (const float*)d_in[10]; p.ssd_norm_w = (const float*)d_in[11]; p.ssd_w_out = (const float*)d_in[12];
    p.sc_w_in = (const float*)d_in[13]; p.sc_conv_w = (const float*)d_in[14]; p.sc_w_out = (const float*)d_in[15]; p.final_w = (const float*)d_in[16];
    p.out = (float*)d_out; p.ws = (unsigned char*)d_ws;
#if ONE_LAUNCH
    p.ph_lo = 0; p.ph_hi = NPH;
    void* args[] = {&p};
    hipError_t e = hipLaunchCooperativeKernel((const void*)mega, dim3(grid), dim3(512), args, LDS_BYTES, stream);
    if (e != hipSuccess) fprintf(stderr, "cooperative launch failed: %s (grid %d)\n", hipGetErrorString(e), grid);
#else
    for (int ph = 0; ph < NPH; ++ph) { if (!phase_active(ph)) continue; p.ph_lo = ph; p.ph_hi = ph + 1; hipLaunchKernelGGL(mega, dim3(grid), dim3(512), LDS_BYTES, stream, p); }
#endif
}
```

```cpp
#include <hip/hip_runtime.h>
#include <hip/hip_cooperative_groups.h>
#include <cstdio>
namespace cg = cooperative_groups;
#ifndef ONE_LAUNCH
#define ONE_LAUNCH 1
#endif
__device__ __forceinline__ int fresh_tid(int wv) { unsigned m = ~0u; asm volatile("" : "+s"(m)); const int lane = (int)__builtin_amdgcn_mbcnt_hi(m, __builtin_amdgcn_mbcnt_lo(m, 0u)); return wv * 64 + lane; }
__device__ __forceinline__ int bid_opaque() { int b = blockIdx.x; asm volatile("" : "+s"(b)); return b; }
namespace pg8 {
#define PG8_LAS __attribute__((address_space(3)))
typedef unsigned short bf16_t;
typedef short bf16x8 __attribute__((ext_vector_type(8)));
typedef float f32x4 __attribute__((ext_vector_type(4)));
typedef unsigned u32x4 __attribute__((ext_vector_type(4)));
constexpr int BM = 256, BK = 64, HALF = 128, HTB = HALF * BK * 2  , STAGE_BYTES = 8 * HTB, NXCD = 8, WGM = 8;

__host__ __device__ __forceinline__ int lds_byte(int r, int c) { const int st = (r >> 4) * 2 + (c >> 5), rr = r & 15, cc = c & 31, ob = rr * 64 + cc * 2; return st * 1024 + (ob ^ (((ob >> 9) & 1) << 5)); }
__host__ __device__ __forceinline__ void stage_rc(int b, int& R, int& C) { const int st = b / 1024, sb = b % 1024, swz = sb ^ (((sb >> 9) & 1) << 5); R = (st >> 1) * 16 + swz / 64; C = (st & 1) * 32 + (swz % 64) / 2; }
__host__ __device__ __forceinline__ int perm32(int rho) { const int n = rho >> 4, i = rho & 15; return 8 * (i >> 2) + 4 * n + (i & 3); }

struct Unit { int pm, pn; };
struct Gemm { const bf16_t* A; const bf16_t* Bt; int M, N, K; };
struct StaticOrder {
    int nM, nN, nwg, G, c;
    __host__ __device__ void init(int M, int N, int G_, int c_) { nM = M / BM; nN = N / BM; nwg = nM * nN; G = G_; c = c_; }
    __host__ __device__ bool next(int i, Unit& u) const {
        const long L = (long)i * G + c; if (L >= nwg) return false;
        int wgid = (int)L; { const int q = nwg / NXCD, r = nwg % NXCD, xcd = wgid % NXCD, off = wgid / NXCD; wgid = (xcd < r ? xcd * (q + 1) : r * (q + 1) + (xcd - r) * q) + off; }
        const int nig = WGM * nN, gid = wgid / nig, fm = gid * WGM, gsz = (nM - fm) < WGM ? (nM - fm) : WGM;
        u.pm = fm + ((wgid % nig) % gsz); u.pn = (wgid % nig) / gsz; return true;
    }
    __device__ __forceinline__ void a_ready(const Unit&) const {}
    __device__ __forceinline__ void done(const Unit&) const {}
};
typedef float f32x2_t __attribute__((ext_vector_type(2)));
typedef __bf16 bf16x2_t __attribute__((ext_vector_type(2)));
__device__ __forceinline__ unsigned cvt_pk_bf16(float lo, float hi) { const f32x2_t f = {lo, hi}; const bf16x2_t b = __builtin_convertvector(f, bf16x2_t); return __builtin_bit_cast(unsigned, b); }
template <class Epi, class Sched, bool STAMP = false>
__device__ __forceinline__ void gemm_phase(PG8_LAS unsigned char* lds, const Gemm g, const Sched& S, const Epi& E, unsigned long long* stamps, int wv) {
    const int tid = fresh_tid(wv), wid = __builtin_amdgcn_readfirstlane(tid >> 6), lane = tid & 63, wr = wid >> 2, wc = wid & 3, fr = lane & 15, fq = lane >> 4;
    const int K = g.K, nt = K / BK;
    int ts_lo = 0, ts_hi = 0, nts = 0; const unsigned long long rt_entry = STAMP ? (unsigned long long)wall_clock64() : 0ull;
#define PG8_STAMP() do { if (STAMP && wid == 0 && nts < 64) { const unsigned long long _c = (unsigned long long)clock64(); \
        ts_lo = (lane == nts) ? (int)(unsigned)_c : ts_lo; ts_hi = (lane == nts) ? (int)(unsigned)(_c >> 32) : ts_hi; ++nts; } } while (0)
    PG8_STAMP();
    unsigned voffA[2], voffB[2];
#pragma unroll
    for (int i = 0; i < 2; ++i) { int R, C; stage_rc(tid * 16 + i * 8192, R, C); const int Rb = Epi::PERM ? ((R & ~31) + perm32(R & 31)) : R;
        voffA[i] = (unsigned)(R * K + C) * 2u; voffB[i] = (unsigned)(Rb * K + C) * 2u; }
    const size_t kstep = (size_t)(BK * 2);
    const size_t hstep = (size_t)HALF * K * 2;
    const size_t tstep = 2 * hstep;
    const unsigned ldsw = (unsigned)wid * 1024u;
    const int aoff = lds_byte(wr * 64 + fr, fq * 8), boff = lds_byte(wc * 32 + fr, fq * 8);
#define PG8_SA(b, h) (((b) * 2 + (h)) * HTB)
#define PG8_SB(b, h) ((4 + (b) * 2 + (h)) * HTB)
#define PG8_STAGE(bufoff, gbase, voff) do { _Pragma("unroll") for (int _i = 0; _i < 2; ++_i) \
        __builtin_amdgcn_global_load_lds((const unsigned*)((const char*)(gbase) + (voff)[_i]), (PG8_LAS unsigned*)(lds + (bufoff) + ldsw + _i * 8192), 16, 0, 0); } while (0)
#define PG8_LDA(dst, b, h) do { _Pragma("unroll") for (int m = 0; m < 4; ++m) _Pragma("unroll") for (int k = 0; k < 2; ++k) dst[m][k] = *(const PG8_LAS bf16x8*)(lds + PG8_SA(b, h) + aoff + m * 2048 + k * 1024); } while (0)
#define PG8_LDB(dst, b, h) do { _Pragma("unroll") for (int n = 0; n < 2; ++n) _Pragma("unroll") for (int k = 0; k < 2; ++k) dst[n][k] = *(const PG8_LAS bf16x8*)(lds + PG8_SB(b, h) + boff + n * 2048 + k * 1024); } while (0)
#define PG8_MMA(ai, bj, At, Bt) do { __builtin_amdgcn_s_setprio(1); _Pragma("unroll") for (int m = 0; m < 4; ++m) _Pragma("unroll") for (int n = 0; n < 2; ++n) _Pragma("unroll") for (int k = 0; k < 2; ++k) \
        acc[ai][bj][m][n] = __builtin_amdgcn_mfma_f32_16x16x32_bf16(Bt[n][k], At[m][k], acc[ai][bj][m][n], 0, 0, 0); __builtin_amdgcn_s_setprio(0); } while (0)
#define PG8_WAIT_V(n) asm volatile("s_waitcnt vmcnt(" #n ")" ::: "memory")
#define PG8_WAIT_L(n) asm volatile("s_waitcnt lgkmcnt(" #n ")" ::: "memory")
#define PG8_BAR __builtin_amdgcn_s_barrier()
#define PG8_SCHED __builtin_amdgcn_sched_barrier(0)
    Unit cur, nxt; int ui = 0;
    if (!S.next(0, cur)) return;
    f32x4 acc[2][2][4][2];
#pragma unroll
    for (int a = 0; a < 2; ++a)
#pragma unroll
        for (int b = 0; b < 2; ++b)
#pragma unroll
            for (int m = 0; m < 4; ++m)
#pragma unroll
                for (int n = 0; n < 2; ++n) acc[a][b][m][n] = (f32x4){0.f, 0.f, 0.f, 0.f};
    bf16x8 At[4][2], B0[2][2], B1[2][2];
    const char* cA = (const char*)g.A + (size_t)cur.pm * tstep; const char* cB = (const char*)g.Bt + (size_t)cur.pn * tstep;
    S.a_ready(cur);
    PG8_STAGE(PG8_SB(0, 0), cB, voffB); PG8_STAGE(PG8_SB(0, 1), cB + hstep, voffB); PG8_STAGE(PG8_SA(0, 0), cA, voffA); PG8_STAGE(PG8_SA(0, 1), cA + hstep, voffA);
    if (wr == 1) PG8_BAR;
    PG8_WAIT_V(2); PG8_BAR;
    PG8_STAGE(PG8_SB(1, 0), cB + kstep, voffB); PG8_STAGE(PG8_SA(1, 0), cA + kstep, voffA); PG8_STAGE(PG8_SB(1, 1), cB + hstep + kstep, voffB);
    PG8_WAIT_V(6); PG8_BAR;
    PG8_STAMP();
    for (;;) {
        const bool has_next = S.next(ui + 1, nxt);
        const char* nA = has_next ? (const char*)g.A + (size_t)nxt.pm * tstep : cA; const char* nB = has_next ? (const char*)g.Bt + (size_t)nxt.pn * tstep : cB;
        for (int t = 0; t < nt; t += 2) {
            const bool last = (t == nt - 2);
            const char* a1 = cA + (size_t)(t + 1) * kstep;
            const char* a2 = last ? nA : cA + (size_t)(t + 2) * kstep; const char* b2 = last ? nB : cB + (size_t)(t + 2) * kstep;
            const char* a3 = a2 + kstep; const char* b3 = b2 + kstep;
            if (last && has_next) S.a_ready(nxt);
            PG8_LDB(B0, 0, 0); PG8_LDB(B1, 0, 1); PG8_SCHED; PG8_LDA(At, 0, 0); PG8_STAGE(PG8_SA(1, 1), a1 + hstep, voffA);
            PG8_WAIT_V(8); PG8_WAIT_L(0); PG8_BAR; PG8_MMA(0, 0, At, B0); PG8_MMA(0, 1, At, B1); PG8_BAR; PG8_SCHED;
            PG8_LDA(At, 0, 1); PG8_STAGE(PG8_SB(0, 0), b2, voffB); PG8_STAGE(PG8_SB(0, 1), b2 + hstep, voffB); PG8_STAGE(PG8_SA(0, 0), a2, voffA);
            PG8_WAIT_V(8); PG8_WAIT_L(0); PG8_BAR; PG8_MMA(1, 0, At, B0); PG8_MMA(1, 1, At, B1); PG8_BAR; PG8_SCHED;
            PG8_LDB(B0, 1, 0); PG8_LDB(B1, 1, 1); PG8_SCHED; PG8_LDA(At, 1, 0); PG8_STAGE(PG8_SA(0, 1), a2 + hstep, voffA);
            PG8_WAIT_V(8); PG8_WAIT_L(0); PG8_BAR; PG8_MMA(0, 0, At, B0); PG8_MMA(0, 1, At, B1); PG8_BAR; PG8_SCHED;
            PG8_LDA(At, 1, 1); PG8_STAGE(PG8_SB(1, 0), b3, voffB); PG8_STAGE(PG8_SB(1, 1), b3 + hstep, voffB); PG8_STAGE(PG8_SA(1, 0), a3, voffA);
            PG8_WAIT_V(8); PG8_WAIT_L(0); PG8_BAR; PG8_MMA(1, 0, At, B0); PG8_MMA(1, 1, At, B1); PG8_BAR; PG8_SCHED;
        }
        PG8_STAMP();
        if (wr == 0) PG8_BAR;
        if constexpr (!Epi::AFTER_DRAIN) { E(acc, cur, wr, wc, fr, fq); S.done(cur); }
        PG8_STAMP();
        if (!has_next) break;
#pragma unroll
        for (int a = 0; a < 2; ++a)
#pragma unroll
            for (int b = 0; b < 2; ++b)
#pragma unroll
                for (int m = 0; m < 4; ++m)
#pragma unroll
                    for (int n = 0; n < 2; ++n) acc[a][b][m][n] = (f32x4){0.f, 0.f, 0.f, 0.f};
        cur = nxt; cA = nA; cB = nB; ++ui;
        if (wr == 1) PG8_BAR;
    }
    PG8_WAIT_V(0);
    PG8_BAR;
    if constexpr (Epi::AFTER_DRAIN) { E.fused(acc, cur, wr, wc, fr, fq, lds, wid, lane); S.done(cur); }
    PG8_STAMP();
    if (STAMP && wid == 0) { stamps[lane] = lane < nts ? (((unsigned long long)(unsigned)ts_hi << 32) | (unsigned)ts_lo) : 0ull;
        if (lane == 62) stamps[62] = rt_entry; if (lane == 63) stamps[63] = (unsigned long long)wall_clock64(); }
#undef PG8_STAMP
#undef PG8_SA
#undef PG8_SB
#undef PG8_STAGE
#undef PG8_LDA
#undef PG8_LDB
#undef PG8_MMA
#undef PG8_WAIT_V
#undef PG8_WAIT_L
#undef PG8_BAR
#undef PG8_SCHED
}
}
#define LAS __attribute__((address_space(3)))
using pg8::bf16_t; using pg8::f32x4; using pg8::u32x4; using pg8::cvt_pk_bf16;
constexpr int S_ = 16384, D_ = 1024, FF_ = 2816, DI_ = 2048, NH_ = 32, CONVD_ = 3072, INP_ = 5376, INSRC_ = 5152;
constexpr float EPS_ = 1e-5f;
constexpr int LDS_CTL = 131072, LDS_BYTES = LDS_CTL + 64;
constexpr int NSLOT = 11, NPH = 4 * NSLOT + 1;

constexpr size_t SZ_GU = (size_t)2 * FF_ * D_ * 2, SZ_D = (size_t)D_ * FF_ * 2, SZ_MIN = (size_t)INP_ * D_ * 2, SZ_MOUT = (size_t)D_ * DI_ * 2;
constexpr size_t WS_GU1 = 0, WS_D1 = WS_GU1 + SZ_GU, WS_GU2 = WS_D1 + SZ_D, WS_D2 = WS_GU2 + SZ_GU, WS_MIN = WS_D2 + SZ_D, WS_MOUT = WS_MIN + SZ_MIN;
constexpr size_t WS_XB = WS_MOUT + SZ_MOUT;
constexpr size_t WS_SS = WS_XB + (size_t)S_ * D_ * 2;
constexpr size_t WS_DT = WS_SS + (size_t)S_ * 16 * 4;
constexpr size_t WS_R1 = WS_DT + (size_t)S_ * 32 * 4;
constexpr size_t WS_R2 = WS_R1 + (size_t)S_ * FF_ * 2;
constexpr size_t WS_R3 = WS_R2 + (size_t)S_ * CONVD_ * 2;
constexpr size_t WS_ACS = WS_R3 + (size_t)S_ * CONVD_ * 2;
constexpr size_t WS_DTT = WS_ACS + (size_t)S_ * 32 * 4;
constexpr size_t WS_RS = WS_DTT + (size_t)S_ * 32 * 4;
constexpr size_t WS_BAR = WS_RS + (size_t)S_ * 4;
constexpr size_t WS_END = WS_BAR + 16384;
constexpr size_t WS_ST = WS_R2;

struct Params {
    const float *x, *norm_w, *wg, *wu, *wd, *ssd_w_in, *ssd_conv_w, *ssd_conv_b, *ssd_dt_bias, *ssd_a_log, *ssd_d, *ssd_norm_w, *ssd_w_out, *sc_w_in, *sc_conv_w, *sc_w_out, *final_w;
    float* out; unsigned char* ws; int ph_lo, ph_hi;
};

__device__ __forceinline__ float bflo(unsigned w) { return __uint_as_float(w << 16); }
__device__ __forceinline__ float bfhi(unsigned w) { return __uint_as_float(w & 0xffff0000u); }
__device__ __forceinline__ float wave_sum(float v) {
#pragma unroll
    for (int o = 1; o < 64; o <<= 1) v += __shfl_xor(v, o);
    return v;
}
__device__ __forceinline__ float silu_f(float v) { return v * __builtin_amdgcn_rcpf(1.0f + __builtin_amdgcn_exp2f(v * -1.44269504089f)); }
__device__ __forceinline__ void unpack8(const u32x4 w, float (&f)[8]) { f[0] = bflo(w.x); f[1] = bfhi(w.x); f[2] = bflo(w.y); f[3] = bfhi(w.y); f[4] = bflo(w.z); f[5] = bfhi(w.z); f[6] = bflo(w.w); f[7] = bfhi(w.w); }

__device__ __forceinline__ int rs_index(int row) { return ((((row >> 8) * 2 + ((row >> 6) & 1)) * 16 + (row & 15)) << 3) + ((row >> 7) & 1) * 4 + ((row >> 4) & 3); }
#define XB_TMO      128
#define XB_XCNT(j)  (256  + 64 * (j))
#define XB_XSUB(j)  (1280 + 64 * (j))
#define XB_XGEN(j)  (2304 + 64 * (j))
#define XB_TOP      3328
#define XB_TOPGEN   3392
#define XCD_BAR_WORDS 3456
#define XB_SPIN_CAP (1u << 18)

__device__ __forceinline__ unsigned xb_ld(unsigned* p)              { return __hip_atomic_load(p, __ATOMIC_RELAXED, __HIP_MEMORY_SCOPE_AGENT); }
__device__ __forceinline__ unsigned xb_add(unsigned* p, unsigned v) { return __hip_atomic_fetch_add(p, v, __ATOMIC_RELAXED, __HIP_MEMORY_SCOPE_AGENT); }
__device__ __forceinline__ unsigned xb_xcc_id() { return (unsigned)__builtin_amdgcn_s_getreg((3 << 11) | 20) & 0xFu; }
#define XB_SPIN(cond, bar) do { unsigned _sp = 0; while (cond) { __builtin_amdgcn_s_sleep(1); \
    if ((++_sp & 255u) == 0u) { if (xb_ld(&(bar)[XB_TMO])) break; if (_sp > XB_SPIN_CAP) { atomicAdd(&(bar)[XB_TMO], 1u); break; } } } } while (0)

struct XcdBarrier {
    unsigned* bar; unsigned x;
    volatile LAS unsigned* st;
};

__device__ __forceinline__ XcdBarrier xcd_barrier_post(unsigned* bar, volatile LAS unsigned* st, bool t0) {
    XcdBarrier b; b.bar = bar; b.x = xb_xcc_id(); b.st = st;
    if (t0) (void)xb_add(&bar[XB_XCNT(b.x)], 1u);
    return b;
}
__device__ __forceinline__ void xcd_barrier_complete(unsigned* bar, unsigned x, unsigned& nloc, unsigned& nx) {
    const unsigned G = gridDim.x * gridDim.y * gridDim.z;
    unsigned sum, cnt, mine, sp = 0u;
    for (;;) {
        sum = 0u; cnt = 0u; mine = 0u;
#pragma unroll
        for (unsigned j = 0; j < 16; ++j) { const unsigned c = xb_ld(&bar[XB_XCNT(j)]); sum += c; cnt += (c > 0u) ? 1u : 0u; mine = (j == x) ? c : mine; }
        if (sum == G) break;
        __builtin_amdgcn_s_sleep(1);
        if ((++sp & 255u) == 0u) { if (xb_ld(&bar[XB_TMO])) break; if (sp > XB_SPIN_CAP) { atomicAdd(&bar[XB_TMO], 1u); break; } }
    }
    nloc = mine > 0u ? mine : 1u; nx = cnt > 0u ? cnt : 1u;
}

__device__ __forceinline__ void xcd_barrier(const XcdBarrier& b, bool t0) {
    asm volatile("s_waitcnt vmcnt(0)" ::: "memory");
    __syncthreads();
    if (t0) {
        unsigned* bar = b.bar;
        __builtin_amdgcn_s_waitcnt(0);
        unsigned nloc = b.st[0], nx = b.st[1];
        if (nloc == 0u) { xcd_barrier_complete(bar, b.x, nloc, nx); b.st[0] = nloc; b.st[1] = nx; }
        const unsigned old = xb_add(&bar[XB_XSUB(b.x)], 1u);
        const unsigned gen = old / nloc;
        if (old + 1u == (gen + 1u) * nloc) {
            __builtin_amdgcn_fence(__ATOMIC_RELEASE, "agent");
            asm volatile("s_waitcnt vmcnt(0)" ::: "memory");
            const unsigned og = xb_add(&bar[XB_TOP], 1u);
            const unsigned tg = og / nx;
            if (og + 1u == (tg + 1u) * nx) xb_add(&bar[XB_TOPGEN], 1u);
            else XB_SPIN(xb_ld(&bar[XB_TOPGEN]) == tg, bar);
            __builtin_amdgcn_fence(__ATOMIC_ACQUIRE, "agent");
            xb_add(&bar[XB_XGEN(b.x)], 1u);
            asm volatile("s_waitcnt vmcnt(0)" ::: "memory");
        } else {
            XB_SPIN(xb_ld(&bar[XB_XGEN(b.x)]) == gen, bar);
            __builtin_amdgcn_fence(__ATOMIC_ACQUIRE, "agent");
            asm volatile("s_waitcnt vmcnt(0)" ::: "memory");
        }
    }
    __syncthreads();
}

struct EpiAll {
    static constexpr bool PERM = true, AFTER_DRAIN = false;
    int mode;
    bf16_t* o0; int ld0, nt0; bf16_t* o1; int ld1, dt_tile;
    float* x; float* ss; float* dt; const float* dt_bias; float scale;
    const float* rsp;
    __device__ __forceinline__ void row_scales(int pm, int wr, int fr, float (&rs)[8]) const {
        const f32x4* q = (const f32x4*)(rsp + (((pm * 2 + wr) * 16 + fr) << 3)); const f32x4 a = q[0], b = q[1];
        rs[0] = a.x; rs[1] = a.y; rs[2] = a.z; rs[3] = a.w; rs[4] = b.x; rs[5] = b.y; rs[6] = b.z; rs[7] = b.w;
        rs[0] = __shfl_xor(rs[0], 16);
    }
    __device__ __forceinline__ void operator()(const f32x4 (&acc)[2][2][4][2], const pg8::Unit& u, int wr, int wc, int fr, int fq) const {
        const int row0 = u.pm * 256 + wr * 64 + fr;
        if (mode == 1) {
            const int col0 = u.pn * 256 + wc * 32 + 8 * fq;
#pragma unroll
            for (int ai = 0; ai < 2; ++ai)
#pragma unroll
                for (int m = 0; m < 4; ++m) {
                    const int row = row0 + ai * 128 + m * 16; float q = 0.f;
#pragma unroll
                    for (int bj = 0; bj < 2; ++bj) {
                        bf16_t* xp = o0 + (size_t)row * D_ + col0 + bj * 128;
                        float xo[8]; unpack8(*(const u32x4*)xp, xo);
                        f32x4 a = (f32x4){xo[0], xo[1], xo[2], xo[3]}, b = (f32x4){xo[4], xo[5], xo[6], xo[7]};
                        a = a + acc[ai][bj][m][0] * scale; b = b + acc[ai][bj][m][1] * scale;
                        q += (a.x * a.x + a.y * a.y) + (a.z * a.z + a.w * a.w) + (b.x * b.x + b.y * b.y) + (b.z * b.z + b.w * b.w);
                        u32x4 w; w.x = cvt_pk_bf16(a.x, a.y); w.y = cvt_pk_bf16(a.z, a.w); w.z = cvt_pk_bf16(b.x, b.y); w.w = cvt_pk_bf16(b.z, b.w);
                        *(u32x4*)xp = w; }
                    q += __shfl_xor(q, 16); q += __shfl_xor(q, 32);
                    if (fq == 0) ss[(size_t)row * 16 + u.pn * 4 + wc] = q; }
            return;
        }
        float rs[8]; row_scales(u.pm, wr, fr, rs);
        if (mode == 0) {
            const int col0 = u.pn * 128 + wc * 32 + 8 * fq;
#pragma unroll
            for (int ai = 0; ai < 2; ++ai)
#pragma unroll
                for (int m = 0; m < 4; ++m) {
                    const int row = row0 + ai * 128 + m * 16; const float r = rs[ai * 4 + m];
                    float o[8];
#pragma unroll
                    for (int n = 0; n < 2; ++n)
#pragma unroll
                        for (int j = 0; j < 4; ++j) { const float g = acc[ai][0][m][n][j] * r, v = acc[ai][1][m][n][j] * r; o[n * 4 + j] = silu_f(g) * v; }
                    u32x4 w; w.x = cvt_pk_bf16(o[0], o[1]); w.y = cvt_pk_bf16(o[2], o[3]); w.z = cvt_pk_bf16(o[4], o[5]); w.w = cvt_pk_bf16(o[6], o[7]);
                    *(u32x4*)(o0 + (size_t)row * ld0 + col0) = w; }
        } else if (u.pn != dt_tile) {
            bf16_t* base; int ld, colt;
            if (u.pn < nt0) { base = o0; ld = ld0; colt = u.pn * 256; } else { base = o1; ld = ld1; colt = (u.pn - nt0) * 256; }
            const int col0 = colt + wc * 32 + 8 * fq;
#pragma unroll
            for (int ai = 0; ai < 2; ++ai)
#pragma unroll
                for (int m = 0; m < 4; ++m) {
                    const int row = row0 + ai * 128 + m * 16; const float r = rs[ai * 4 + m];
#pragma unroll
                    for (int bj = 0; bj < 2; ++bj) {
                        const f32x4 a = acc[ai][bj][m][0] * r, b = acc[ai][bj][m][1] * r;
                        u32x4 w; w.x = cvt_pk_bf16(a.x, a.y); w.y = cvt_pk_bf16(a.z, a.w); w.z = cvt_pk_bf16(b.x, b.y); w.w = cvt_pk_bf16(b.z, b.w);
                        *(u32x4*)(base + (size_t)row * ld + col0 + bj * 128) = w; } }
        } else if (wc == 0) {
            const f32x4 b0 = *(const f32x4*)(dt_bias + 8 * fq), b1 = *(const f32x4*)(dt_bias + 8 * fq + 4);
#pragma unroll
            for (int ai = 0; ai < 2; ++ai)
#pragma unroll
                for (int m = 0; m < 4; ++m) {
                    const int row = row0 + ai * 128 + m * 16; const float r = rs[ai * 4 + m];
                    f32x4 a = acc[ai][0][m][0] * r + b0, b = acc[ai][0][m][1] * r + b1;
#pragma unroll
                    for (int j = 0; j < 4; ++j) { a[j] = fmaxf(a[j], 0.f) + log1pf(__expf(-fabsf(a[j]))); b[j] = fmaxf(b[j], 0.f) + log1pf(__expf(-fabsf(b[j]))); }
                    float* o = dt + (size_t)row * 32 + 8 * fq; *(f32x4*)o = a; *(f32x4*)(o + 4) = b; }
        }
    }
};

template <class Epi> __device__ __forceinline__ void run_gemm(LAS unsigned char* lds, const bf16_t* A, const bf16_t* Bt, int N, int K, const Epi& E, int wv) {
    pg8::Gemm g; g.A = A; g.Bt = Bt; g.M = S_; g.N = N; g.K = K;
    pg8::StaticOrder S; S.init(S_, N, (int)gridDim.x, (int)blockIdx.x);
    pg8::gemm_phase<Epi, pg8::StaticOrder, false>(lds, g, S, E, nullptr, wv);
}

__device__ __forceinline__ void tr_item(const float* W, int ldw, int k0, int scol0, const float* scale, bf16_t* WT, int K, int drow0, LAS float* scr, int lane) {
    float v[32];
    const float* wp = W + (size_t)(k0 + (lane >> 5)) * ldw + scol0 + (lane & 31);
#pragma unroll
    for (int i = 0; i < 32; ++i) v[i] = wp[(size_t)(2 * i) * ldw];
    if (scale) {
#pragma unroll
        for (int i = 0; i < 32; ++i) v[i] *= scale[k0 + 2 * i + (lane >> 5)]; }
#pragma unroll
    for (int i = 0; i < 32; ++i) scr[(2 * i + (lane >> 5)) * 33 + (lane & 31)] = v[i];
    asm volatile("s_waitcnt lgkmcnt(0)" ::: "memory");
    const int c = lane & 7;
#pragma unroll
    for (int j = 0; j < 4; ++j) { const int n = (lane >> 3) + 8 * j; const LAS float* s = scr + (8 * c) * 33 + n;
        u32x4 o; o.x = cvt_pk_bf16(s[0 * 33], s[1 * 33]); o.y = cvt_pk_bf16(s[2 * 33], s[3 * 33]); o.z = cvt_pk_bf16(s[4 * 33], s[5 * 33]); o.w = cvt_pk_bf16(s[6 * 33], s[7 * 33]);
        *(u32x4*)(WT + (size_t)(drow0 + n) * K + k0 + 8 * c) = o; }
    asm volatile("s_waitcnt lgkmcnt(0)" ::: "memory");
}

__device__ __forceinline__ void rs_phase(const Params& p, int wv) {
    const float* ss = (const float*)(p.ws + WS_SS); float* rsp = (float*)(p.ws + WS_RS);
    for (int t = bid_opaque() * 512 + fresh_tid(wv); t < S_ * 8; t += gridDim.x * 512) {
        const int row = t >> 3, part = t & 7; const float* q = ss + (size_t)row * 16 + 2 * part;
        float v = q[0] + q[1]; v += __shfl_xor(v, 1); v += __shfl_xor(v, 2); v += __shfl_xor(v, 4);
        if (part == 0) rsp[rs_index(row)] = rsqrtf(v * (1.0f / D_) + EPS_);
    }
}
__device__ __forceinline__ void prep_phase(const Params& p, int layer, LAS unsigned char* lds, int wv) {
    const int lane = fresh_tid(wv) & 63, wave = fresh_tid(wv) >> 6;
    LAS float* scr = (LAS float*)(lds + wave * 8448);
    const int gw = bid_opaque() * 8 + wave, NGW = gridDim.x * 8;
    const bool ssd = !(layer & 1); const int j = layer >> 1;
    const float* nw = p.norm_w + (size_t)layer * 3 * D_;
    constexpr int I_GU = (D_ / 64) * (FF_ / 32), I_D = (FF_ / 64) * (D_ / 32);
    const int nbin = ssd ? INSRC_ / 32 : CONVD_ / 32, I_MIN = (D_ / 64) * nbin, kout = ssd ? DI_ : D_, I_MOUT = (kout / 64) * (D_ / 32);
    const int total = 4 * I_GU + 2 * I_D + I_MIN + I_MOUT;
    for (int it = gw; it < total; it += NGW) {
        int r = it;
        if (r < 4 * I_GU) { const int which = r / I_GU; r -= which * I_GU; const int f = which >> 1, s = which & 1;
            const float* W = (s ? p.wu : p.wg) + (size_t)(layer * 2 + f) * D_ * FF_;
            const int kb = r / (FF_ / 32), nb = r - kb * (FF_ / 32), h0 = nb * 32, drow0 = 256 * (h0 >> 7) + 128 * s + (h0 & 127);
            tr_item(W, FF_, kb * 64, h0, nw + (f ? 2 * D_ : 0), (bf16_t*)(p.ws + (f ? WS_GU2 : WS_GU1)), D_, drow0, scr, lane); continue; }
        r -= 4 * I_GU;
        if (r < 2 * I_D) { const int f = r / I_D; r -= f * I_D;
            const float* W = p.wd + (size_t)(layer * 2 + f) * FF_ * D_;
            const int kb = r / (D_ / 32), nb = r - kb * (D_ / 32);
            tr_item(W, D_, kb * 64, nb * 32, nullptr, (bf16_t*)(p.ws + (f ? WS_D2 : WS_D1)), FF_, nb * 32, scr, lane); continue; }
        r -= 2 * I_D;
        if (r < I_MIN) { const int kb = r / nbin, nb = r - kb * nbin;
            const float* W = ssd ? p.ssd_w_in + (size_t)j * D_ * INSRC_ : p.sc_w_in + (size_t)j * D_ * CONVD_;
            tr_item(W, ssd ? INSRC_ : CONVD_, kb * 64, nb * 32, nw + D_, (bf16_t*)(p.ws + WS_MIN), D_, nb * 32, scr, lane); continue; }
        r -= I_MIN;
        { const int kb = r / (D_ / 32), nb = r - kb * (D_ / 32);
            const float* W = ssd ? p.ssd_w_out + (size_t)j * DI_ * D_ : p.sc_w_out + (size_t)j * D_ * D_;
            tr_item(W, D_, kb * 64, nb * 32, nullptr, (bf16_t*)(p.ws + WS_MOUT), kout, nb * 32, scr, lane); }
    }
    if (layer == 0) {
        bf16_t* xb = (bf16_t*)(p.ws + WS_XB); float* ss = (float*)(p.ws + WS_SS);
        for (int row = gw; row < S_; row += NGW) {
            const f32x4* xr = (const f32x4*)(p.x + (size_t)row * D_) + lane;
            unsigned long long* o8 = (unsigned long long*)(xb + (size_t)row * D_) + lane; float s = 0.f;
#pragma unroll
            for (int q = 0; q < 4; ++q) { const f32x4 v = xr[64 * q]; s += (v.x * v.x + v.y * v.y) + (v.z * v.z + v.w * v.w);
                o8[64 * q] = (unsigned long long)cvt_pk_bf16(v.x, v.y) | ((unsigned long long)cvt_pk_bf16(v.z, v.w) << 32); }
            s = wave_sum(s);
            if (lane < 16) ss[(size_t)row * 16 + lane] = lane == 0 ? s : 0.f;
            if (lane == 0) ((float*)(p.ws + WS_RS))[rs_index(row)] = rsqrtf(s * (1.0f / D_) + EPS_);
        }
    } else rs_phase(p, wv);
}

__device__ __forceinline__ u32x4 pack8(const float (&f)[8]) { u32x4 w; w.x = cvt_pk_bf16(f[0], f[1]); w.y = cvt_pk_bf16(f[2], f[3]); w.z = cvt_pk_bf16(f[4], f[5]); w.w = cvt_pk_bf16(f[6], f[7]); return w; }

__device__ __forceinline__ void sc_conv_phase(const Params& p, int j, int wv) {
    const bf16_t* bcu = (const bf16_t*)(p.ws + WS_R2); bf16_t* vo = (bf16_t*)(p.ws + WS_R1); const float* cw = p.sc_conv_w + (size_t)j * 3 * D_;
    const int nthr = gridDim.x * 512;
    for (int idx = bid_opaque() * 512 + fresh_tid(wv); idx < (S_ / 16) * 128; idx += nthr) {
        const int tb = idx >> 7, c = (idx & 127) * 8, t0 = tb * 16;
        float w[3][8];
#pragma unroll
        for (int k = 0; k < 3; ++k) { const f32x4 w0 = *(const f32x4*)(cw + k * D_ + c), w1 = *(const f32x4*)(cw + k * D_ + c + 4);
#pragma unroll
            for (int e = 0; e < 4; ++e) { w[k][e] = w0[e]; w[k][4 + e] = w1[e]; } }
        float h0[8], h1[8];
#pragma unroll
        for (int e = 0; e < 8; ++e) { h0[e] = 0.f; h1[e] = 0.f; }
        if (t0 > 0) { float a[8], b[8];
            unpack8(*(const u32x4*)(bcu + (size_t)(t0 - 2) * CONVD_ + D_ + c), a); unpack8(*(const u32x4*)(bcu + (size_t)(t0 - 2) * CONVD_ + 2 * D_ + c), b);
#pragma unroll
            for (int e = 0; e < 8; ++e) h0[e] = a[e] * b[e];
            unpack8(*(const u32x4*)(bcu + (size_t)(t0 - 1) * CONVD_ + D_ + c), a); unpack8(*(const u32x4*)(bcu + (size_t)(t0 - 1) * CONVD_ + 2 * D_ + c), b);
#pragma unroll
            for (int e = 0; e < 8; ++e) h1[e] = a[e] * b[e]; }
        const bf16_t* row = bcu + (size_t)t0 * CONVD_ + c; bf16_t* orow = vo + (size_t)t0 * D_ + c;
#pragma unroll 8
        for (int r = 0; r < 16; ++r) {
            float bg[8], cgv[8], uv[8], o[8];
            unpack8(*(const u32x4*)(row + (size_t)r * CONVD_), bg); unpack8(*(const u32x4*)(row + (size_t)r * CONVD_ + D_), cgv); unpack8(*(const u32x4*)(row + (size_t)r * CONVD_ + 2 * D_), uv);
#pragma unroll
            for (int e = 0; e < 8; ++e) { const float cu = cgv[e] * uv[e]; o[e] = bg[e] * (w[0][e] * h0[e] + w[1][e] * h1[e] + w[2][e] * cu); h0[e] = h1[e]; h1[e] = cu; }
            *(u32x4*)(orow + (size_t)r * D_) = pack8(o);
        }
    }
}
__device__ __forceinline__ void ssd_conv_phase(const Params& p, int j, int wv) {
    const bf16_t* raw = (const bf16_t*)(p.ws + WS_R2); bf16_t* xo = (bf16_t*)(p.ws + WS_R3);
    const float* cw = p.ssd_conv_w + (size_t)j * 4 * CONVD_; const float* cb = p.ssd_conv_b + (size_t)j * CONVD_;
    const int nthr = gridDim.x * 512;
    for (int idx = bid_opaque() * 512 + fresh_tid(wv); idx < (S_ / 64) * 384; idx += nthr) {
        const int tb = idx / 384, c = (idx - tb * 384) * 8, t0 = tb * 64;
        float w[4][8], bias[8];
#pragma unroll
        for (int k = 0; k < 4; ++k) { const f32x4 w0 = *(const f32x4*)(cw + k * CONVD_ + c), w1 = *(const f32x4*)(cw + k * CONVD_ + c + 4);
#pragma unroll
            for (int e = 0; e < 4; ++e) { w[k][e] = w0[e]; w[k][4 + e] = w1[e]; } }
        { const f32x4 b0 = *(const f32x4*)(cb + c), b1 = *(const f32x4*)(cb + c + 4);
#pragma unroll
          for (int e = 0; e < 4; ++e) { bias[e] = b0[e]; bias[4 + e] = b1[e]; } }
        float h0[8], h1[8], h2[8];
#pragma unroll
        for (int e = 0; e < 8; ++e) { h0[e] = 0.f; h1[e] = 0.f; h2[e] = 0.f; }
        if (t0 > 0) { unpack8(*(const u32x4*)(raw + (size_t)(t0 - 3) * CONVD_ + c), h0); unpack8(*(const u32x4*)(raw + (size_t)(t0 - 2) * CONVD_ + c), h1); unpack8(*(const u32x4*)(raw + (size_t)(t0 - 1) * CONVD_ + c), h2); }
        const bf16_t* row = raw + (size_t)t0 * CONVD_ + c; bf16_t* orow = xo + (size_t)t0 * CONVD_ + c;
#pragma unroll 8
        for (int r = 0; r < 64; ++r) {
            float v[8], o[8]; unpack8(*(const u32x4*)(row + (size_t)r * CONVD_), v);
#pragma unroll
            for (int e = 0; e < 8; ++e) { o[e] = silu_f(bias[e] + w[0][e] * h0[e] + w[1][e] * h1[e] + w[2][e] * h2[e] + w[3][e] * v[e]); h0[e] = h1[e]; h1[e] = h2[e]; h2[e] = v[e]; }
            *(u32x4*)(orow + (size_t)r * CONVD_) = pack8(o);
        }
    }
}
__device__ __forceinline__ void ssd_dt_phase(const Params& p, int j, int wv) {
    const int tid = fresh_tid(wv), lane = tid & 63, wave = tid >> 6, fr = lane & 15, fq = lane >> 4;
    const bf16_t* xb = (const bf16_t*)(p.ws + WS_XB); const bf16_t* wdt = (const bf16_t*)(p.ws + WS_MIN) + (size_t)5120 * D_; const float* ss = (const float*)(p.ws + WS_SS); float* dt = (float*)(p.ws + WS_DT);
    const float* bias = p.ssd_dt_bias + j * NH_;
    for (int tile = bid_opaque() * 8 + wave; tile < S_ / 16; tile += gridDim.x * 8) {
        const int r0 = tile * 16;
        const bf16_t* ap = xb + (size_t)(r0 + fr) * D_ + 8 * fq; const bf16_t* bp = wdt + (size_t)fr * D_ + 8 * fq;
        f32x4 acc0 = (f32x4){0.f, 0.f, 0.f, 0.f}, acc1 = acc0;
#pragma unroll 8
        for (int ks = 0; ks < 32; ++ks) {
            const pg8::bf16x8 a = *(const pg8::bf16x8*)(ap + ks * 32), b0 = *(const pg8::bf16x8*)(bp + ks * 32), b1 = *(const pg8::bf16x8*)(bp + 16 * D_ + ks * 32);
            acc0 = __builtin_amdgcn_mfma_f32_16x16x32_bf16(b0, a, acc0, 0, 0, 0); acc1 = __builtin_amdgcn_mfma_f32_16x16x32_bf16(b1, a, acc1, 0, 0, 0);
        }
        const float rs = ((const float*)(p.ws + WS_RS))[rs_index(r0 + fr)];
        const f32x4 bb0 = *(const f32x4*)(bias + 4 * fq), bb1 = *(const f32x4*)(bias + 16 + 4 * fq);
        f32x4 a = acc0 * rs + bb0, b = acc1 * rs + bb1;
#pragma unroll
        for (int e = 0; e < 4; ++e) { a[e] = fmaxf(a[e], 0.f) + log1pf(__expf(-fabsf(a[e]))); b[e] = fmaxf(b[e], 0.f) + log1pf(__expf(-fabsf(b[e]))); }
        float* o = dt + (size_t)(r0 + fr) * 32 + 4 * fq; *(f32x4*)o = a; *(f32x4*)(o + 16) = b;
    }
}
__device__ __forceinline__ void ssd_acs_phase(const Params& p, int j, int wv) {
    const float* dt = (const float*)(p.ws + WS_DT); float* acsT = (float*)(p.ws + WS_ACS); float* dtT = (float*)(p.ws + WS_DTT);
    const int tid = fresh_tid(wv), lane = tid & 63, wave = tid >> 6;
    for (int it = bid_opaque() * 8 + wave; it < 128 * NH_; it += gridDim.x * 8) {
        const int c = it >> 5, h = it & 31; const float a = -__expf(p.ssd_a_log[j * NH_ + h]);
        const size_t t0 = (size_t)c * 128 + 2 * lane; const float d0 = dt[t0 * 32 + h], d1 = dt[(t0 + 1) * 32 + h];
        const float v0 = d0 * a, v1 = d1 * a; float s = v0 + v1;
#pragma unroll
        for (int o = 1; o < 64; o <<= 1) { const float t = __shfl_up(s, o); if (lane >= o) s += t; }
        const float ex = s - (v0 + v1); const size_t o = (size_t)it * 128 + 2 * lane;
        acsT[o] = ex + v0; acsT[o + 1] = ex + v0 + v1; dtT[o] = d0; dtT[o + 1] = d1;
    }
}
typedef short s16x4 __attribute__((ext_vector_type(4)));
__device__ __forceinline__ pg8::bf16x8 tr8(LAS unsigned char* lane_base, int off, int stride) {
    const s16x4 lo = __builtin_amdgcn_ds_read_tr16_b64_v4i16((LAS s16x4*)(lane_base + off));
    const s16x4 hi = __builtin_amdgcn_ds_read_tr16_b64_v4i16((LAS s16x4*)(lane_base + off + 4 * stride));
    pg8::bf16x8 r; r[0] = lo[0]; r[1] = lo[1]; r[2] = lo[2]; r[3] = lo[3]; r[4] = hi[0]; r[5] = hi[1]; r[6] = hi[2]; r[7] = hi[3]; return r;
}
__device__ __forceinline__ unsigned long long pack4(const f32x4 v) { return (unsigned long long)cvt_pk_bf16(v.x, v.y) | ((unsigned long long)cvt_pk_bf16(v.z, v.w) << 32); }
constexpr int XS_STRIDE = 1056, BS_STRIDE = 160, CS_STRIDE = 272;
__device__ __forceinline__ void ssd_states_phase(const Params& p, LAS unsigned char* lds, int wv) {
    const int tid = fresh_tid(wv), lane = tid & 63, wave = tid >> 6, fr = lane & 15, fq = lane >> 4;
    const bf16_t* xc = (const bf16_t*)(p.ws + WS_R3); const float* acsT = (const float*)(p.ws + WS_ACS); const float* dtT = (const float*)(p.ws + WS_DTT); bf16_t* st = (bf16_t*)(p.ws + WS_ST);
    LAS unsigned char* Xs = lds; LAS unsigned char* Bs = lds + 64 * XS_STRIDE; LAS float* wt = (LAS float*)(lds + 64 * XS_STRIDE + 64 * BS_STRIDE);
    LAS unsigned char* trB = Bs + (8 * fq + (fr >> 2)) * BS_STRIDE + 8 * (lane & 3);
    LAS unsigned char* trX = Xs + (8 * fq + (fr >> 2)) * XS_STRIDE + 8 * (lane & 3) + wave * 128;
#pragma unroll 1
    for (int it = bid_opaque(); it < 1024; it += gridDim.x) {
        const int item = 2 * (it % 512) + it / 512 * 0 + ((it >= 512) ? 1 : 0);
        const int c = item >> 3, g = (item >> 1) & 3, nh = item & 1;
        __syncthreads();
        for (int i = tid; i < 1024; i += 512) { const int e = i >> 7, l = i & 127; const size_t o = (size_t)(c * 32 + g * 8 + e) * 128; wt[i] = dtT[o + l] * __expf(acsT[o + 127] - acsT[o + l]); }
        f32x4 acc[4][4];
#pragma unroll
        for (int a = 0; a < 4; ++a)
#pragma unroll
            for (int b = 0; b < 4; ++b) acc[a][b] = (f32x4){0.f, 0.f, 0.f, 0.f};
#pragma unroll 1
        for (int half = 0; half < 2; ++half) {
            __syncthreads();
            {
                const int ch = tid & 63, r0 = tid >> 6;
                const bf16_t* xsrc = xc + (size_t)(c * 128 + half * 64 + r0) * CONVD_ + g * 512 + ch * 8;
                u32x4 v[8];
#pragma unroll
                for (int u = 0; u < 8; ++u) v[u] = *(const u32x4*)(xsrc + (size_t)u * 8 * CONVD_);
                const int rb = tid >> 3, cb8 = tid & 7;
                const u32x4 bv = *(const u32x4*)(xc + (size_t)(c * 128 + half * 64 + rb) * CONVD_ + DI_ + g * 128 + nh * 64 + cb8 * 8);
#pragma unroll
                for (int u = 0; u < 8; ++u) { float f[8]; unpack8(v[u], f); const float w = wt[(ch >> 3) * 128 + half * 64 + r0 + 8 * u];
#pragma unroll
                    for (int e = 0; e < 8; ++e) f[e] *= w;
                    *(LAS u32x4*)(Xs + (r0 + 8 * u) * XS_STRIDE + ch * 16) = pack8(f); }
                *(LAS u32x4*)(Bs + rb * BS_STRIDE + cb8 * 16) = bv;
            }
            __syncthreads();
#pragma unroll
            for (int ks = 0; ks < 2; ++ks) {
                pg8::bf16x8 ap[4];
#pragma unroll
                for (int pt = 0; pt < 4; ++pt) ap[pt] = tr8(trX, ks * 32 * XS_STRIDE + pt * 32, XS_STRIDE);
#pragma unroll
                for (int nt = 0; nt < 4; ++nt) { const pg8::bf16x8 bn = tr8(trB, ks * 32 * BS_STRIDE + nt * 32, BS_STRIDE);
#pragma unroll
                    for (int pt = 0; pt < 4; ++pt) acc[pt][nt] = __builtin_amdgcn_mfma_f32_16x16x32_bf16(bn, ap[pt], acc[pt][nt], 0, 0, 0); }
            }
        }
        bf16_t* so = st + (size_t)(c * 32 + g * 8 + wave) * 64 * 128 + fr * 128 + nh * 64 + 4 * fq;
#pragma unroll
        for (int pt = 0; pt < 4; ++pt)
#pragma unroll
            for (int nt = 0; nt < 4; ++nt) *(unsigned long long*)(so + pt * 16 * 128 + nt * 16) = pack4(acc[pt][nt]);
    }
}
__device__ __forceinline__ void ssd_cscan_phase(const Params& p, int wv) {
    const float* acsT = (const float*)(p.ws + WS_ACS); bf16_t* st = (bf16_t*)(p.ws + WS_ST);
    for (int e2 = bid_opaque() * 512 + fresh_tid(wv); e2 < NH_ * 4096; e2 += gridDim.x * 512) {
        const int h = e2 >> 12, rem = e2 & 4095; float r0 = 0.f, r1 = 0.f;
#pragma unroll 8
        for (int c = 0; c < 128; ++c) {
            unsigned* ptr = (unsigned*)(st + (size_t)(c * 32 + h) * 8192 + 2 * rem); const unsigned v = *ptr; const float d = __expf(acsT[(size_t)(c * 32 + h) * 128 + 127]);
            *ptr = cvt_pk_bf16(r0, r1); r0 = d * r0 + bflo(v); r1 = d * r1 + bfhi(v);
        }
    }
}
__device__ __forceinline__ void ssd_yout_phase(const Params& p, int j, LAS unsigned char* lds, int wv) {
    const int tid = fresh_tid(wv), lane = tid & 63, wave = tid >> 6, fr = lane & 15, fq = lane >> 4;
    const bf16_t* xc = (const bf16_t*)(p.ws + WS_R3); const float* acsT = (const float*)(p.ws + WS_ACS); const float* dtT = (const float*)(p.ws + WS_DTT);
    const bf16_t* st = (const bf16_t*)(p.ws + WS_ST); bf16_t* zg = (bf16_t*)(p.ws + WS_R1); const float* nw = p.ssd_norm_w + (size_t)j * DI_;
    LAS unsigned char* Cs = lds; LAS unsigned char* CBs = lds + 64 * CS_STRIDE; LAS unsigned char* Xs = lds + 128 * CS_STRIDE; LAS unsigned char* Bs = Xs;
    LAS float* acs_t = (LAS float*)(lds + 128 * CS_STRIDE + 64 * XS_STRIDE); LAS float* dt_t = acs_t + 1024; LAS float* red = dt_t + 1024;
    LAS unsigned char* cfb = Cs + fr * CS_STRIDE + 16 * fq;
    LAS unsigned char* bfb = Bs + fr * CS_STRIDE + 16 * fq;
    LAS unsigned char* cbr = CBs + fr * CS_STRIDE + 16 * fq;
    LAS unsigned char* trX = Xs + (8 * fq + (fr >> 2)) * XS_STRIDE + 8 * (lane & 3) + wave * 128;
    LAS float* redw = red + fr * 8;
#pragma unroll 1
    for (int it = bid_opaque(); it < 1024; it += gridDim.x) {
        const int item = 2 * (it % 512) + ((it >= 512) ? 1 : 0);
        const int c = item >> 3, g = (item >> 1) & 3, lh = item & 1, h = g * 8 + wave; const size_t trow = (size_t)c * 128; const int lbase = 64 * lh;
        LAS float* acl = acs_t + wave * 128 + lbase + fr;
        LAS float* acq = acs_t + wave * 128 + 8 * fq;
        __syncthreads();
        {
            const int r = tid >> 4, ch = tid & 15;
            const bf16_t* bsrc = xc + (trow + r) * CONVD_ + DI_ + g * 128 + ch * 8; const bf16_t* csrc = xc + (trow + lbase + r) * CONVD_ + DI_ + 512 + g * 128 + ch * 8;
            const size_t o = (size_t)(c * 32 + g * 8) * 128 + tid;
            u32x4 bv[4], cv[2];
#pragma unroll
            for (int u = 0; u < 4; ++u) bv[u] = (u < 2 || lh) ? *(const u32x4*)(bsrc + (size_t)u * 32 * CONVD_) : (u32x4){0u, 0u, 0u, 0u};
#pragma unroll
            for (int u = 0; u < 2; ++u) cv[u] = *(const u32x4*)(csrc + (size_t)u * 32 * CONVD_);
            const float a0 = acsT[o], a1 = acsT[o + 512], d0 = dtT[o], d1 = dtT[o + 512];
#pragma unroll
            for (int u = 0; u < 4; ++u) *(LAS u32x4*)(Bs + (r + 32 * u) * CS_STRIDE + ch * 16) = bv[u];
#pragma unroll
            for (int u = 0; u < 2; ++u) *(LAS u32x4*)(Cs + (r + 32 * u) * CS_STRIDE + ch * 16) = cv[u];
            acs_t[tid] = a0; acs_t[tid + 512] = a1; dt_t[tid] = d0; dt_t[tid + 512] = d1;
        }
        __syncthreads();
        {
            const int lt = wave & 3, sg = wave >> 2, mt = 4 * lh + lt;
            pg8::bf16x8 cf[4];
#pragma unroll
            for (int ks = 0; ks < 4; ++ks) cf[ks] = *(const LAS pg8::bf16x8*)(cfb + lt * 16 * CS_STRIDE + ks * 64);
#pragma unroll
            for (int si = 0; si < 4; ++si) {
                const int s8 = 4 * sg + si;
                if (s8 <= (mt | 1)) {
                    f32x4 a = (f32x4){0.f, 0.f, 0.f, 0.f};
#pragma unroll
                    for (int ks = 0; ks < 4; ++ks) { const pg8::bf16x8 bf = *(const LAS pg8::bf16x8*)(bfb + s8 * 16 * CS_STRIDE + ks * 64); a = __builtin_amdgcn_mfma_f32_16x16x32_bf16(bf, cf[ks], a, 0, 0, 0); }
                    *(LAS unsigned long long*)(CBs + (lt * 16 + fr) * CS_STRIDE + (s8 * 16 + 4 * fq) * 2) = pack4(a);
                }
            }
        }
        f32x4 acc[4][4];
#pragma unroll
        for (int a = 0; a < 4; ++a)
#pragma unroll
            for (int b = 0; b < 4; ++b) acc[a][b] = (f32x4){0.f, 0.f, 0.f, 0.f};
        {
            const bf16_t* pv = st + (size_t)(c * 32 + h) * 8192 + fr * 128 + 8 * fq;
#pragma unroll
            for (int ks = 0; ks < 4; ++ks) {
                pg8::bf16x8 pf[4];
#pragma unroll
                for (int pt = 0; pt < 4; ++pt) pf[pt] = *(const pg8::bf16x8*)(pv + pt * 16 * 128 + ks * 32);
#pragma unroll
                for (int lt = 0; lt < 4; ++lt) { const pg8::bf16x8 cf = *(const LAS pg8::bf16x8*)(cfb + lt * 16 * CS_STRIDE + ks * 64);
#pragma unroll
                    for (int pt = 0; pt < 4; ++pt) acc[lt][pt] = __builtin_amdgcn_mfma_f32_16x16x32_bf16(pf[pt], cf, acc[lt][pt], 0, 0, 0); }
            }
#pragma unroll
            for (int lt = 0; lt < 4; ++lt) { const float sc = __expf(acl[lt * 16]);
#pragma unroll
                for (int pt = 0; pt < 4; ++pt) acc[lt][pt] = acc[lt][pt] * sc; }
        }
#pragma unroll 1
        for (int half = 0; half <= lh; ++half) {
            __syncthreads();
            {
                const int ch = tid & 63, r0 = tid >> 6;
                const bf16_t* xsrc = xc + (trow + half * 64 + r0) * CONVD_ + g * 512 + ch * 8;
                u32x4 v[8];
#pragma unroll
                for (int u = 0; u < 8; ++u) v[u] = *(const u32x4*)(xsrc + (size_t)u * 8 * CONVD_);
#pragma unroll
                for (int u = 0; u < 8; ++u) { float f[8]; unpack8(v[u], f); const float w = dt_t[(ch >> 3) * 128 + half * 64 + r0 + 8 * u];
#pragma unroll
                    for (int e = 0; e < 8; ++e) f[e] *= w;
                    *(LAS u32x4*)(Xs + (r0 + 8 * u) * XS_STRIDE + ch * 16) = pack8(f); }
            }
            __syncthreads();
#pragma unroll
            for (int kk = 0; kk < 2; ++kk) {
                const int kt = 2 * half + kk;
                pg8::bf16x8 xf[4];
#pragma unroll
                for (int pt = 0; pt < 4; ++pt) xf[pt] = tr8(trX, kk * 32 * XS_STRIDE + pt * 32, XS_STRIDE);
                const f32x4 as0 = *(const LAS f32x4*)(acq + kt * 32), as1 = *(const LAS f32x4*)(acq + kt * 32 + 4);
                const float asv[8] = {as0.x, as0.y, as0.z, as0.w, as1.x, as1.y, as1.z, as1.w};
#pragma unroll
                for (int lt = 0; lt < 4; ++lt) {
                    const int mt = 4 * lh + lt;
                    if (mt >= 2 * kt) {
                        const int dl = mt * 16 + fr - kt * 32 - 8 * fq;
                        const float al = acl[lt * 16];
                        float cb[8]; unpack8(*(const LAS u32x4*)(cbr + lt * 16 * CS_STRIDE + kt * 64), cb);
#pragma unroll
                        for (int e = 0; e < 8; ++e) cb[e] = (e <= dl) ? cb[e] * __expf(fminf(al - asv[e], 0.f)) : 0.f;
                        const u32x4 pw = pack8(cb); const pg8::bf16x8 pfr = __builtin_bit_cast(pg8::bf16x8, pw);
#pragma unroll
                        for (int pt = 0; pt < 4; ++pt) acc[lt][pt] = __builtin_amdgcn_mfma_f32_16x16x32_bf16(xf[pt], pfr, acc[lt][pt], 0, 0, 0);
                    }
                }
            }
        }
        const float Dh = p.ssd_d[j * NH_ + h];
        const bf16_t* xrow = xc + (trow + lbase + fr) * CONVD_ + h * 64 + 4 * fq; bf16_t* zrow = zg + (trow + lbase + fr) * DI_ + h * 64 + 4 * fq;
#pragma unroll
        for (int lt = 0; lt < 4; ++lt) {
            float q = 0.f;
#pragma unroll
            for (int pt = 0; pt < 4; ++pt) {
                const unsigned long long xv = *(const unsigned long long*)(xrow + (size_t)lt * 16 * CONVD_ + pt * 16), zv = *(const unsigned long long*)(zrow + (size_t)lt * 16 * DI_ + pt * 16);
                const float x4[4] = {bflo((unsigned)xv), bfhi((unsigned)xv), bflo((unsigned)(xv >> 32)), bfhi((unsigned)(xv >> 32))};
                const float z4[4] = {bflo((unsigned)zv), bfhi((unsigned)zv), bflo((unsigned)(zv >> 32)), bfhi((unsigned)(zv >> 32))};
#pragma unroll
                for (int e = 0; e < 4; ++e) { const float y = (acc[lt][pt][e] + Dh * x4[e]) * silu_f(z4[e]); acc[lt][pt][e] = y; q += y * y; }
            }
            q += __shfl_xor(q, 16); q += __shfl_xor(q, 32);
            if (fq == 0) redw[lt * 128 + wave] = q;
        }
        __syncthreads();
        const float* nwl = nw + h * 64 + 4 * fq;
#pragma unroll
        for (int lt = 0; lt < 4; ++lt) {
            const f32x4 r0 = *(const LAS f32x4*)(redw + lt * 128), r1 = *(const LAS f32x4*)(redw + lt * 128 + 4);
            const float rs = rsqrtf((((r0.x + r0.y) + (r0.z + r0.w)) + ((r1.x + r1.y) + (r1.z + r1.w))) * (1.0f / 512.f) + EPS_);
#pragma unroll
            for (int pt = 0; pt < 4; ++pt) { const f32x4 w = *(const f32x4*)(nwl + pt * 16);
                *(unsigned long long*)(zrow + (size_t)lt * 16 * DI_ + pt * 16) = pack4(acc[lt][pt] * rs * w); }
        }
    }
}
__device__ __forceinline__ void final_phase(const Params& p, int wv) {
    const int tid = fresh_tid(wv), lane = tid & 63, wave = tid >> 6; const bf16_t* xb = (const bf16_t*)(p.ws + WS_XB);
    for (int row = bid_opaque() * 8 + wave; row < S_; row += gridDim.x * 8) {
        const u32x4* xr = (const u32x4*)(xb + (size_t)row * D_) + lane; f32x4* orow = (f32x4*)(p.out + (size_t)row * D_) + 2 * lane; const f32x4* wr = (const f32x4*)p.final_w + 2 * lane;
        float v[2][8]; float s = 0.f;
#pragma unroll
        for (int q = 0; q < 2; ++q) { unpack8(xr[64 * q], v[q]);
#pragma unroll
            for (int e = 0; e < 8; ++e) s += v[q][e] * v[q][e]; }
        const float rs = rsqrtf(wave_sum(s) * (1.0f / D_) + EPS_);
#pragma unroll
        for (int q = 0; q < 2; ++q) { const f32x4 w0 = wr[128 * q], w1 = wr[128 * q + 1];
            orow[128 * q] = (f32x4){v[q][0], v[q][1], v[q][2], v[q][3]} * rs * w0; orow[128 * q + 1] = (f32x4){v[q][4], v[q][5], v[q][6], v[q][7]} * rs * w1; }
    }
}

__host__ __device__ inline bool phase_active(int ph) { if (ph >= NPH - 1) return ph == NPH - 1; const int layer = ph / NSLOT, k = ph % NSLOT; return !((layer & 1) && (k >= 5 && k <= 7)); }

__device__ __forceinline__ void run_phase(const Params& p, int ph, LAS unsigned char* lds, int wv) {
    if (ph == NPH - 1) { final_phase(p, wv); return; }
    const int layer = ph / NSLOT, k = ph - layer * NSLOT, j = layer >> 1; const bool ssd = !(layer & 1);
    bf16_t* xb = (bf16_t*)(p.ws + WS_XB); float* ss = (float*)(p.ws + WS_SS);
    const int kk = k;
    EpiAll E{}; E.ss = ss; E.rsp = (const float*)(p.ws + WS_RS); E.x = p.out; E.dt = (float*)(p.ws + WS_DT); E.dt_bias = p.ssd_dt_bias + j * NH_; E.dt_tile = -1; E.scale = 1.0f;
    const bf16_t* A = xb; const bf16_t* Bt = nullptr; int N = 0, K = D_; bool gemm = true;
    switch (kk) {
    case 1: case 9: E.mode = 0; E.o0 = (bf16_t*)(p.ws + WS_R1); E.ld0 = FF_; Bt = (const bf16_t*)(p.ws + (kk == 1 ? WS_GU1 : WS_GU2)); N = 2 * FF_; break;
    case 2: case 10: E.mode = 1; E.o0 = xb; E.scale = 0.5f; A = (const bf16_t*)(p.ws + WS_R1); Bt = (const bf16_t*)(p.ws + (kk == 2 ? WS_D1 : WS_D2)); N = D_; K = FF_; break;
    case 3: E.mode = 2; Bt = (const bf16_t*)(p.ws + WS_MIN);
            if (ssd) { E.o0 = (bf16_t*)(p.ws + WS_R1); E.ld0 = DI_; E.nt0 = 8; E.o1 = (bf16_t*)(p.ws + WS_R2); E.ld1 = CONVD_; N = DI_ + CONVD_; }
            else { E.o0 = (bf16_t*)(p.ws + WS_R2); E.ld0 = CONVD_; E.nt0 = 12; E.o1 = E.o0; E.ld1 = CONVD_; N = CONVD_; } break;
    case 8: E.mode = 1; E.o0 = xb; A = (const bf16_t*)(p.ws + WS_R1); Bt = (const bf16_t*)(p.ws + WS_MOUT); N = D_; K = ssd ? DI_ : D_; break;
    default: gemm = false; break;
    }
    if (gemm) { run_gemm(lds, A, Bt, N, K, E, wv); if (kk == 3 && ssd) ssd_dt_phase(p, j, wv); return; }
    switch (kk) {
    case 0: prep_phase(p, layer, lds, wv); break;
    case 4: if (ssd) { ssd_conv_phase(p, j, wv); ssd_acs_phase(p, j, wv); } else sc_conv_phase(p, j, wv); break;
    case 5: if (ssd) ssd_states_phase(p, lds, wv); break;
    case 6: if (ssd) ssd_cscan_phase(p, wv); break;
    case 7: if (ssd) ssd_yout_phase(p, j, lds, wv); break;
    }
}

__global__ __launch_bounds__(512, 2) void mega(Params p) {
    extern __shared__ __attribute__((aligned(16))) unsigned char shm[];
    LAS unsigned char* lds = (LAS unsigned char*)shm;
    cg::grid_group grid = cg::this_grid();
    const int wv = __builtin_amdgcn_readfirstlane((int)(threadIdx.x >> 6));
    const bool t0 = (threadIdx.x == 0);
    if (threadIdx.x < 16) ((LAS unsigned*)(lds + LDS_CTL))[threadIdx.x] = 0u;
    __syncthreads();
    XcdBarrier xb = xcd_barrier_post((unsigned*)(p.ws + WS_BAR), (volatile LAS unsigned*)(lds + LDS_CTL), t0);
    bool first = true;
    for (int ph = p.ph_lo; ph < p.ph_hi; ++ph) {
        if (!phase_active(ph)) continue;
        { const int k = ph % NSLOT; if (ph < NPH - 1 && (k == 3 || k == 9)) { rs_phase(p, wv); xcd_barrier(xb, fresh_tid(wv) == 0); } }
        run_phase(p, ph, lds, wv);
        if (ph + 1 < p.ph_hi) {
            if (first) { __syncthreads(); grid.sync(); first = false; }
            else xcd_barrier(xb, fresh_tid(wv) == 0);
        }
    }
}

extern "C" void kernel_launch(void* const* d_in, const int* in_sizes, int n_in, void* d_out, int out_size, void* d_ws, size_t ws_size, hipStream_t stream) {
    static int grid = 0;
    if (grid == 0) {
        int dev = 0, cus = 0, per_cu = 0;
        hipGetDevice(&dev); hipDeviceGetAttribute(&cus, hipDeviceAttributeMultiprocessorCount, dev);
        hipFuncSetAttribute((const void*)mega, hipFuncAttributeMaxDynamicSharedMemorySize, LDS_BYTES);
        hipOccupancyMaxActiveBlocksPerMultiprocessor(&per_cu, (const void*)mega, 512, LDS_BYTES);
        if (per_cu < 1) per_cu = 1;
        grid = cus * per_cu;
        if (ws_size < WS_END) fprintf(stderr, "kernel_launch: workspace too small: %zu < %zu\n", ws_size, (size_t)WS_END);
        (void)hipGetLastError();
    }
    (void)hipMemsetAsync((unsigned char*)d_ws + WS_BAR, 0, 16384, stream);
    Params p{};
    p.x = (const float*)d_in[0]; p.norm_w = (const float*)d_in[1]; p.wg = (const float*)d_in[2]; p.wu = (const float*)d_in[3]; p.wd = (const float*)d_in[4];
    p.ssd_w_in = (const float*)d_in[5]; p.ssd_conv_w = (const float*)d_in[6]; p.ssd_conv_b = (const float*)d_in[7]; p.ssd_dt_bias = (const float*)d_in[8];
    p.ssd_a_log = (const float*)d_in[9]; p.ssd_d = (const float*)d_in[10]; p.ssd_norm_w = (const float*)d_in[11]; p.ssd_w_out = (const float*)d_in[12];
    p.sc_w_in = (const float*)d_in[13]; p.sc_conv_w = (const float*)d_in[14]; p.sc_w_out = (const float*)d_in[15]; p.final_w = (const float*)d_in[16];
    p.out = (float*)d_out; p.ws = (unsigned char*)d_ws;
#if ONE_LAUNCH
    p.ph_lo = 0; p.ph_hi = NPH;
    void* args[] = {&p};
    hipError_t e = hipLaunchCooperativeKernel((const void*)mega, dim3(grid), dim3(512), args, LDS_BYTES, stream);
    if (e != hipSuccess) fprintf(stderr, "cooperative launch failed: %s (grid %d)\n", hipGetErrorString(e), grid);
#else
    for (int ph = 0; ph < NPH; ++ph) { if (!phase_active(ph)) continue; p.ph_lo = ph; p.ph_hi = ph + 1; hipLaunchKernelGGL(mega, dim3(grid), dim3(512), LDS_BYTES, stream, p); }
#endif
}
```

```cpp
#include <hip/hip_runtime.h>
#include <hip/hip_cooperative_groups.h>
#include <cstdio>
namespace cg = cooperative_groups;
#ifndef ONE_LAUNCH
#define ONE_LAUNCH 1
#endif
__device__ __forceinline__ int fresh_tid(int wv) { unsigned m = ~0u; asm volatile("" : "+s"(m)); const int lane = (int)__builtin_amdgcn_mbcnt_hi(m, __builtin_amdgcn_mbcnt_lo(m, 0u)); return wv * 64 + lane; }
__device__ __forceinline__ int bid_opaque() { int b = blockIdx.x; asm volatile("" : "+s"(b)); return b; }
namespace pg8 {
#define PG8_LAS __attribute__((address_space(3)))
typedef unsigned short bf16_t;
typedef short bf16x8 __attribute__((ext_vector_type(8)));
typedef float f32x4 __attribute__((ext_vector_type(4)));
typedef unsigned u32x4 __attribute__((ext_vector_type(4)));
constexpr int BM = 256, BK = 64, HALF = 128, HTB = HALF * BK * 2  , STAGE_BYTES = 8 * HTB, NXCD = 8, WGM = 8;

__host__ __device__ __forceinline__ int lds_byte(int r, int c) { const int st = (r >> 4) * 2 + (c >> 5), rr = r & 15, cc = c & 31, ob = rr * 64 + cc * 2; return st * 1024 + (ob ^ (((ob >> 9) & 1) << 5)); }
__host__ __device__ __forceinline__ void stage_rc(int b, int& R, int& C) { const int st = b / 1024, sb = b % 1024, swz = sb ^ (((sb >> 9) & 1) << 5); R = (st >> 1) * 16 + swz / 64; C = (st & 1) * 32 + (swz % 64) / 2; }
__host__ __device__ __forceinline__ int perm32(int rho) { const int n = rho >> 4, i = rho & 15; return 8 * (i >> 2) + 4 * n + (i & 3); }

struct Unit { int pm, pn; };
struct Gemm { const bf16_t* A; const bf16_t* Bt; int M, N, K; };
struct StaticOrder {
    int nM, nN, nwg, G, c;
    __host__ __device__ void init(int M, int N, int G_, int c_) { nM = M / BM; nN = N / BM; nwg = nM * nN; G = G_; c = c_; }
    __host__ __device__ bool next(int i, Unit& u) const {
        const long L = (long)i * G + c; if (L >= nwg) return false;
        int wgid = (int)L; { const int q = nwg / NXCD, r = nwg % NXCD, xcd = wgid % NXCD, off = wgid / NXCD; wgid = (xcd < r ? xcd * (q + 1) : r * (q + 1) + (xcd - r) * q) + off; }
        const int nig = WGM * nN, gid = wgid / nig, fm = gid * WGM, gsz = (nM - fm) < WGM ? (nM - fm) : WGM;
        u.pm = fm + ((wgid % nig) % gsz); u.pn = (wgid % nig) / gsz; return true;
    }
    __device__ __forceinline__ void a_ready(const Unit&) const {}
    __device__ __forceinline__ void done(const Unit&) const {}
};
typedef float f32x2_t __attribute__((ext_vector_type(2)));
typedef __bf16 bf16x2_t __attribute__((ext_vector_type(2)));
__device__ __forceinline__ unsigned cvt_pk_bf16(float lo, float hi) { const f32x2_t f = {lo, hi}; const bf16x2_t b = __builtin_convertvector(f, bf16x2_t); return __builtin_bit_cast(unsigned, b); }
template <class Epi, class Sched, bool STAMP = false>
__device__ __forceinline__ void gemm_phase(PG8_LAS unsigned char* lds, const Gemm g, const Sched& S, const Epi& E, unsigned long long* stamps, int wv) {
    const int tid = fresh_tid(wv), wid = __builtin_amdgcn_readfirstlane(tid >> 6), lane = tid & 63, wr = wid >> 2, wc = wid & 3, fr = lane & 15, fq = lane >> 4;
    const int K = g.K, nt = K / BK;
    int ts_lo = 0, ts_hi = 0, nts = 0; const unsigned long long rt_entry = STAMP ? (unsigned long long)wall_clock64() : 0ull;
#define PG8_STAMP() do { if (STAMP && wid == 0 && nts < 64) { const unsigned long long _c = (unsigned long long)clock64(); \
        ts_lo = (lane == nts) ? (int)(unsigned)_c : ts_lo; ts_hi = (lane == nts) ? (int)(unsigned)(_c >> 32) : ts_hi; ++nts; } } while (0)
    PG8_STAMP();
    unsigned voffA[2], voffB[2];
#pragma unroll
    for (int i = 0; i < 2; ++i) { int R, C; stage_rc(tid * 16 + i * 8192, R, C); const int Rb = Epi::PERM ? ((R & ~31) + perm32(R & 31)) : R;
        voffA[i] = (unsigned)(R * K + C) * 2u; voffB[i] = (unsigned)(Rb * K + C) * 2u; }
    const size_t kstep = (size_t)(BK * 2);
    const size_t hstep = (size_t)HALF * K * 2;
    const size_t tstep = 2 * hstep;
    const unsigned ldsw = (unsigned)wid * 1024u;
    const int aoff = lds_byte(wr * 64 + fr, fq * 8), boff = lds_byte(wc * 32 + fr, fq * 8);
#define PG8_SA(b, h) (((b) * 2 + (h)) * HTB)
#define PG8_SB(b, h) ((4 + (b) * 2 + (h)) * HTB)
#define PG8_STAGE(bufoff, gbase, voff) do { _Pragma("unroll") for (int _i = 0; _i < 2; ++_i) \
        __builtin_amdgcn_global_load_lds((const unsigned*)((const char*)(gbase) + (voff)[_i]), (PG8_LAS unsigned*)(lds + (bufoff) + ldsw + _i * 8192), 16, 0, 0); } while (0)
#define PG8_LDA(dst, b, h) do { _Pragma("unroll") for (int m = 0; m < 4; ++m) _Pragma("unroll") for (int k = 0; k < 2; ++k) dst[m][k] = *(const PG8_LAS bf16x8*)(lds + PG8_SA(b, h) + aoff + m * 2048 + k * 1024); } while (0)
#define PG8_LDB(dst, b, h) do { _Pragma("unroll") for (int n = 0; n < 2; ++n) _Pragma("unroll") for (int k = 0; k < 2; ++k) dst[n][k] = *(const PG8_LAS bf16x8*)(lds + PG8_SB(b, h) + boff + n * 2048 + k * 1024); } while (0)
#define PG8_MMA(ai, bj, At, Bt) do { __builtin_amdgcn_s_setprio(1); _Pragma("unroll") for (int m = 0; m < 4; ++m) _Pragma("unroll") for (int n = 0; n < 2; ++n) _Pragma("unroll") for (int k = 0; k < 2; ++k) \
        acc[ai][bj][m][n] = __builtin_amdgcn_mfma_f32_16x16x32_bf16(Bt[n][k], At[m][k], acc[ai][bj][m][n], 0, 0, 0); __builtin_amdgcn_s_setprio(0); } while (0)
#define PG8_WAIT_V(n) asm volatile("s_waitcnt vmcnt(" #n ")" ::: "memory")
#define PG8_WAIT_L(n) asm volatile("s_waitcnt lgkmcnt(" #n ")" ::: "memory")
#define PG8_BAR __builtin_amdgcn_s_barrier()
#define PG8_SCHED __builtin_amdgcn_sched_barrier(0)
    Unit cur, nxt; int ui = 0;
    if (!S.next(0, cur)) return;
    f32x4 acc[2][2][4][2];
#pragma unroll
    for (int a = 0; a < 2; ++a)
#pragma unroll
        for (int b = 0; b < 2; ++b)
#pragma unroll
            for (int m = 0; m < 4; ++m)
#pragma unroll
                for (int n = 0; n < 2; ++n) acc[a][b][m][n] = (f32x4){0.f, 0.f, 0.f, 0.f};
    bf16x8 At[4][2], B0[2][2], B1[2][2];
    const char* cA = (const char*)g.A + (size_t)cur.pm * tstep; const char* cB = (const char*)g.Bt + (size_t)cur.pn * tstep;
    S.a_ready(cur);
    PG8_STAGE(PG8_SB(0, 0), cB, voffB); PG8_STAGE(PG8_SB(0, 1), cB + hstep, voffB); PG8_STAGE(PG8_SA(0, 0), cA, voffA); PG8_STAGE(PG8_SA(0, 1), cA + hstep, voffA);
    if (wr == 1) PG8_BAR;
    PG8_WAIT_V(2); PG8_BAR;
    PG8_STAGE(PG8_SB(1, 0), cB + kstep, voffB); PG8_STAGE(PG8_SA(1, 0), cA + kstep, voffA); PG8_STAGE(PG8_SB(1, 1), cB + hstep + kstep, voffB);
    PG8_WAIT_V(6); PG8_BAR;
    PG8_STAMP();
    for (;;) {
        const bool has_next = S.next(ui + 1, nxt);
        const char* nA = has_next ? (const char*)g.A + (size_t)nxt.pm * tstep : cA; const char* nB = has_next ? (const char*)g.Bt + (size_t)nxt.pn * tstep : cB;
        for (int t = 0; t < nt; t += 2) {
            const bool last = (t == nt - 2);
            const char* a1 = cA + (size_t)(t + 1) * kstep;
            const char* a2 = last ? nA : cA + (size_t)(t + 2) * kstep; const char* b2 = last ? nB : cB + (size_t)(t + 2) * kstep;
            const char* a3 = a2 + kstep; const char* b3 = b2 + kstep;
            if (last && has_next) S.a_ready(nxt);
            PG8_LDB(B0, 0, 0); PG8_LDB(B1, 0, 1); PG8_SCHED; PG8_LDA(At, 0, 0); PG8_STAGE(PG8_SA(1, 1), a1 + hstep, voffA);
            PG8_WAIT_V(8); PG8_WAIT_L(0); PG8_BAR; PG8_MMA(0, 0, At, B0); PG8_MMA(0, 1, At, B1); PG8_BAR; PG8_SCHED;
            PG8_LDA(At, 0, 1); PG8_STAGE(PG8_SB(0, 0), b2, voffB); PG8_STAGE(PG8_SB(0, 1), b2 + hstep, voffB); PG8_STAGE(PG8_SA(0, 0), a2, voffA);
            PG8_WAIT_V(8); PG8_WAIT_L(0); PG8_BAR; PG8_MMA(1, 0, At, B0); PG8_MMA(1, 1, At, B1); PG8_BAR; PG8_SCHED;
            PG8_LDB(B0, 1, 0); PG8_LDB(B1, 1, 1); PG8_SCHED; PG8_LDA(At, 1, 0); PG8_STAGE(PG8_SA(0, 1), a2 + hstep, voffA);
            PG8_WAIT_V(8); PG8_WAIT_L(0); PG8_BAR; PG8_MMA(0, 0, At, B0); PG8_MMA(0, 1, At, B1); PG8_BAR; PG8_SCHED;
            PG8_LDA(At, 1, 1); PG8_STAGE(PG8_SB(1, 0), b3, voffB); PG8_STAGE(PG8_SB(1, 1), b3 + hstep, voffB); PG8_STAGE(PG8_SA(1, 0), a3, voffA);
            PG8_WAIT_V(8); PG8_WAIT_L(0); PG8_BAR; PG8_MMA(1, 0, At, B0); PG8_MMA(1, 1, At, B1); PG8_BAR; PG8_SCHED;
        }
        PG8_STAMP();
        if (wr == 0) PG8_BAR;
        if constexpr (!Epi::AFTER_DRAIN) { E(acc, cur, wr, wc, fr, fq); S.done(cur); }
        PG8_STAMP();
        if (!has_next) break;
#pragma unroll
        for (int a = 0; a < 2; ++a)
#pragma unroll
            for (int b = 0; b < 2; ++b)
#pragma unroll
                for (int m = 0; m < 4; ++m)
#pragma unroll
                    for (int n = 0; n < 2; ++n) acc[a][b][m][n] = (f32x4){0.f, 0.f, 0.f, 0.f};
        cur = nxt; cA = nA; cB = nB; ++ui;
        if (wr == 1) PG8_BAR;
    }
    PG8_WAIT_V(0);
    PG8_BAR;
    if constexpr (Epi::AFTER_DRAIN) { E.fused(acc, cur, wr, wc, fr, fq, lds, wid, lane); S.done(cur); }
    PG8_STAMP();
    if (STAMP && wid == 0) { stamps[lane] = lane < nts ? (((unsigned long long)(unsigned)ts_hi << 32) | (unsigned)ts_lo) : 0ull;
        if (lane == 62) stamps[62] = rt_entry; if (lane == 63) stamps[63] = (unsigned long long)wall_clock64(); }
#undef PG8_STAMP
#undef PG8_SA
#undef PG8_SB
#undef PG8_STAGE
#undef PG8_LDA
#undef PG8_LDB
#undef PG8_MMA
#undef PG8_WAIT_V
#undef PG8_WAIT_L
#undef PG8_BAR
#undef PG8_SCHED
}
}
#define LAS __attribute__((address_space(3)))
using pg8::bf16_t; using pg8::f32x4; using pg8::u32x4; using pg8::cvt_pk_bf16;
constexpr int S_ = 16384, D_ = 1024, FF_ = 2816, DI_ = 2048, NH_ = 32, CONVD_ = 3072, INP_ = 5376, INSRC_ = 5152;
constexpr float EPS_ = 1e-5f;
constexpr int LDS_CTL = 131072, LDS_BYTES = LDS_CTL + 64;
constexpr int NSLOT = 11, NPH = 4 * NSLOT + 1;

constexpr size_t SZ_GU = (size_t)2 * FF_ * D_ * 2, SZ_D = (size_t)D_ * FF_ * 2, SZ_MIN = (size_t)INP_ * D_ * 2, SZ_MOUT = (size_t)D_ * DI_ * 2;
constexpr size_t WS_GU1 = 0, WS_D1 = WS_GU1 + SZ_GU, WS_GU2 = WS_D1 + SZ_D, WS_D2 = WS_GU2 + SZ_GU, WS_MIN = WS_D2 + SZ_D, WS_MOUT = WS_MIN + SZ_MIN;
constexpr size_t WS_XB = WS_MOUT + SZ_MOUT;
constexpr size_t WS_SS = WS_XB + (size_t)S_ * D_ * 2;
constexpr size_t WS_DT = WS_SS + (size_t)S_ * 16 * 4;
constexpr size_t WS_R1 = WS_DT + (size_t)S_ * 32 * 4;
constexpr size_t WS_R2 = WS_R1 + (size_t)S_ * FF_ * 2;
constexpr size_t WS_R3 = WS_R2 + (size_t)S_ * CONVD_ * 2;
constexpr size_t WS_ACS = WS_R3 + (size_t)S_ * CONVD_ * 2;
constexpr size_t WS_DTT = WS_ACS + (size_t)S_ * 32 * 4;
constexpr size_t WS_RS = WS_DTT + (size_t)S_ * 32 * 4;
constexpr size_t WS_BAR = WS_RS + (size_t)S_ * 4;
constexpr size_t WS_W1 = WS_BAR + 16384;
constexpr size_t WS_WSZ = WS_XB;
constexpr size_t WS_END = WS_W1 + WS_WSZ;
__host__ __device__ inline size_t wofs(int layer) { return (layer & 1) ? WS_W1 : (size_t)0; }
constexpr int PREP_N1 = 3072, PREP_N2 = 6144;
constexpr size_t WS_ST = WS_R2;

struct Params {
    const float *x, *norm_w, *wg, *wu, *wd, *ssd_w_in, *ssd_conv_w, *ssd_conv_b, *ssd_dt_bias, *ssd_a_log, *ssd_d, *ssd_norm_w, *ssd_w_out, *sc_w_in, *sc_conv_w, *sc_w_out, *final_w;
    float* out; unsigned char* ws; int ph_lo, ph_hi;
};

__device__ __forceinline__ float bflo(unsigned w) { return __uint_as_float(w << 16); }
__device__ __forceinline__ float bfhi(unsigned w) { return __uint_as_float(w & 0xffff0000u); }
__device__ __forceinline__ float wave_sum(float v) {
#pragma unroll
    for (int o = 1; o < 64; o <<= 1) v += __shfl_xor(v, o);
    return v;
}
__device__ __forceinline__ float silu_f(float v) { return v * __builtin_amdgcn_rcpf(1.0f + __builtin_amdgcn_exp2f(v * -1.44269504089f)); }
__device__ __forceinline__ void unpack8(const u32x4 w, float (&f)[8]) { f[0] = bflo(w.x); f[1] = bfhi(w.x); f[2] = bflo(w.y); f[3] = bfhi(w.y); f[4] = bflo(w.z); f[5] = bfhi(w.z); f[6] = bflo(w.w); f[7] = bfhi(w.w); }

__device__ __forceinline__ int rs_index(int row) { return ((((row >> 8) * 2 + ((row >> 6) & 1)) * 16 + (row & 15)) << 3) + ((row >> 7) & 1) * 4 + ((row >> 4) & 3); }
#define XB_TMO      128
#define XB_XCNT(j)  (256  + 64 * (j))
#define XB_XSUB(j)  (1280 + 64 * (j))
#define XB_XGEN(j)  (2304 + 64 * (j))
#define XB_TOP      3328
#define XB_TOPGEN   3392
#define XCD_BAR_WORDS 3456
#define XB_SPIN_CAP (1u << 18)

__device__ __forceinline__ unsigned xb_ld(unsigned* p)              { return __hip_atomic_load(p, __ATOMIC_RELAXED, __HIP_MEMORY_SCOPE_AGENT); }
__device__ __forceinline__ unsigned xb_add(unsigned* p, unsigned v) { return __hip_atomic_fetch_add(p, v, __ATOMIC_RELAXED, __HIP_MEMORY_SCOPE_AGENT); }
__device__ __forceinline__ unsigned xb_xcc_id() { return (unsigned)__builtin_amdgcn_s_getreg((3 << 11) | 20) & 0xFu; }
#define XB_SPIN(cond, bar) do { unsigned _sp = 0; while (cond) { __builtin_amdgcn_s_sleep(1); \
    if ((++_sp & 255u) == 0u) { if (xb_ld(&(bar)[XB_TMO])) break; if (_sp > XB_SPIN_CAP) { atomicAdd(&(bar)[XB_TMO], 1u); break; } } } } while (0)

struct XcdBarrier {
    unsigned* bar; unsigned x;
    volatile LAS unsigned* st;
};

__device__ __forceinline__ XcdBarrier xcd_barrier_post(unsigned* bar, volatile LAS unsigned* st, bool t0) {
    XcdBarrier b; b.bar = bar; b.x = xb_xcc_id(); b.st = st;
    if (t0) (void)xb_add(&bar[XB_XCNT(b.x)], 1u);
    return b;
}
__device__ __forceinline__ void xcd_barrier_complete(unsigned* bar, unsigned x, unsigned& nloc, unsigned& nx) {
    const unsigned G = gridDim.x * gridDim.y * gridDim.z;
    unsigned sum, cnt, mine, sp = 0u;
    for (;;) {
        sum = 0u; cnt = 0u; mine = 0u;
#pragma unroll
        for (unsigned j = 0; j < 16; ++j) { const unsigned c = xb_ld(&bar[XB_XCNT(j)]); sum += c; cnt += (c > 0u) ? 1u : 0u; mine = (j == x) ? c : mine; }
        if (sum == G) break;
        __builtin_amdgcn_s_sleep(1);
        if ((++sp & 255u) == 0u) { if (xb_ld(&bar[XB_TMO])) break; if (sp > XB_SPIN_CAP) { atomicAdd(&bar[XB_TMO], 1u); break; } }
    }
    nloc = mine > 0u ? mine : 1u; nx = cnt > 0u ? cnt : 1u;
}

__device__ __forceinline__ void xcd_barrier(const XcdBarrier& b, bool t0) {
    asm volatile("s_waitcnt vmcnt(0)" ::: "memory");
    __syncthreads();
    if (t0) {
        unsigned* bar = b.bar;
        __builtin_amdgcn_s_waitcnt(0);
        unsigned nloc = b.st[0], nx = b.st[1];
        if (nloc == 0u) { xcd_barrier_complete(bar, b.x, nloc, nx); b.st[0] = nloc; b.st[1] = nx; }
        const unsigned old = xb_add(&bar[XB_XSUB(b.x)], 1u);
        const unsigned gen = old / nloc;
        if (old + 1u == (gen + 1u) * nloc) {
            __builtin_amdgcn_fence(__ATOMIC_RELEASE, "agent");
            asm volatile("s_waitcnt vmcnt(0)" ::: "memory");
            const unsigned og = xb_add(&bar[XB_TOP], 1u);
            const unsigned tg = og / nx;
            if (og + 1u == (tg + 1u) * nx) xb_add(&bar[XB_TOPGEN], 1u);
            else XB_SPIN(xb_ld(&bar[XB_TOPGEN]) == tg, bar);
            __builtin_amdgcn_fence(__ATOMIC_ACQUIRE, "agent");
            xb_add(&bar[XB_XGEN(b.x)], 1u);
            asm volatile("s_waitcnt vmcnt(0)" ::: "memory");
        } else {
            XB_SPIN(xb_ld(&bar[XB_XGEN(b.x)]) == gen, bar);
            __builtin_amdgcn_fence(__ATOMIC_ACQUIRE, "agent");
            asm volatile("s_waitcnt vmcnt(0)" ::: "memory");
        }
    }
    __syncthreads();
}

struct EpiAll {
    static constexpr bool PERM = true, AFTER_DRAIN = false;
    int mode;
    bf16_t* o0; int ld0, nt0; bf16_t* o1; int ld1, dt_tile;
    float* x; float* ss; float* dt; const float* dt_bias; float scale;
    const float* rsp;
    __device__ __forceinline__ void row_scales(int pm, int wr, int fr, float (&rs)[8]) const {
        const f32x4* q = (const f32x4*)(rsp + (((pm * 2 + wr) * 16 + fr) << 3)); const f32x4 a = q[0], b = q[1];
        rs[0] = a.x; rs[1] = a.y; rs[2] = a.z; rs[3] = a.w; rs[4] = b.x; rs[5] = b.y; rs[6] = b.z; rs[7] = b.w;
        rs[0] = __shfl_xor(rs[0], 16);
    }
    __device__ __forceinline__ void operator()(const f32x4 (&acc)[2][2][4][2], const pg8::Unit& u, int wr, int wc, int fr, int fq) const {
        const int row0 = u.pm * 256 + wr * 64 + fr;
        if (mode == 1) {
            const int col0 = u.pn * 256 + wc * 32 + 8 * fq;
#pragma unroll
            for (int ai = 0; ai < 2; ++ai)
#pragma unroll
                for (int m = 0; m < 4; ++m) {
                    const int row = row0 + ai * 128 + m * 16; float q = 0.f;
#pragma unroll
                    for (int bj = 0; bj < 2; ++bj) {
                        bf16_t* xp = o0 + (size_t)row * D_ + col0 + bj * 128;
                        float xo[8]; unpack8(*(const u32x4*)xp, xo);
                        f32x4 a = (f32x4){xo[0], xo[1], xo[2], xo[3]}, b = (f32x4){xo[4], xo[5], xo[6], xo[7]};
                        a = a + acc[ai][bj][m][0] * scale; b = b + acc[ai][bj][m][1] * scale;
                        q += (a.x * a.x + a.y * a.y) + (a.z * a.z + a.w * a.w) + (b.x * b.x + b.y * b.y) + (b.z * b.z + b.w * b.w);
                        u32x4 w; w.x = cvt_pk_bf16(a.x, a.y); w.y = cvt_pk_bf16(a.z, a.w); w.z = cvt_pk_bf16(b.x, b.y); w.w = cvt_pk_bf16(b.z, b.w);
                        *(u32x4*)xp = w; }
                    q += __shfl_xor(q, 16); q += __shfl_xor(q, 32);
                    if (fq == 0) ss[(size_t)row * 16 + u.pn * 4 + wc] = q; }
            return;
        }
        float rs[8]; row_scales(u.pm, wr, fr, rs);
        if (mode == 0) {
            const int col0 = u.pn * 128 + wc * 32 + 8 * fq;
#pragma unroll
            for (int ai = 0; ai < 2; ++ai)
#pragma unroll
                for (int m = 0; m < 4; ++m) {
                    const int row = row0 + ai * 128 + m * 16; const float r = rs[ai * 4 + m];
                    float o[8];
#pragma unroll
                    for (int n = 0; n < 2; ++n)
#pragma unroll
                        for (int j = 0; j < 4; ++j) { const float g = acc[ai][0][m][n][j] * r, v = acc[ai][1][m][n][j] * r; o[n * 4 + j] = silu_f(g) * v; }
                    u32x4 w; w.x = cvt_pk_bf16(o[0], o[1]); w.y = cvt_pk_bf16(o[2], o[3]); w.z = cvt_pk_bf16(o[4], o[5]); w.w = cvt_pk_bf16(o[6], o[7]);
                    *(u32x4*)(o0 + (size_t)row * ld0 + col0) = w; }
        } else if (u.pn != dt_tile) {
            bf16_t* base; int ld, colt;
            if (u.pn < nt0) { base = o0; ld = ld0; colt = u.pn * 256; } else { base = o1; ld = ld1; colt = (u.pn - nt0) * 256; }
            const int col0 = colt + wc * 32 + 8 * fq;
#pragma unroll
            for (int ai = 0; ai < 2; ++ai)
#pragma unroll
                for (int m = 0; m < 4; ++m) {
                    const int row = row0 + ai * 128 + m * 16; const float r = rs[ai * 4 + m];
#pragma unroll
                    for (int bj = 0; bj < 2; ++bj) {
                        const f32x4 a = acc[ai][bj][m][0] * r, b = acc[ai][bj][m][1] * r;
                        u32x4 w; w.x = cvt_pk_bf16(a.x, a.y); w.y = cvt_pk_bf16(a.z, a.w); w.z = cvt_pk_bf16(b.x, b.y); w.w = cvt_pk_bf16(b.z, b.w);
                        *(u32x4*)(base + (size_t)row * ld + col0 + bj * 128) = w; } }
        } else if (wc == 0) {
            const f32x4 b0 = *(const f32x4*)(dt_bias + 8 * fq), b1 = *(const f32x4*)(dt_bias + 8 * fq + 4);
#pragma unroll
            for (int ai = 0; ai < 2; ++ai)
#pragma unroll
                for (int m = 0; m < 4; ++m) {
                    const int row = row0 + ai * 128 + m * 16; const float r = rs[ai * 4 + m];
                    f32x4 a = acc[ai][0][m][0] * r + b0, b = acc[ai][0][m][1] * r + b1;
#pragma unroll
                    for (int j = 0; j < 4; ++j) { a[j] = fmaxf(a[j], 0.f) + log1pf(__expf(-fabsf(a[j]))); b[j] = fmaxf(b[j], 0.f) + log1pf(__expf(-fabsf(b[j]))); }
                    float* o = dt + (size_t)row * 32 + 8 * fq; *(f32x4*)o = a; *(f32x4*)(o + 4) = b; }
        }
    }
};

template <class Epi> __device__ __forceinline__ void run_gemm(LAS unsigned char* lds, const bf16_t* A, const bf16_t* Bt, int N, int K, const Epi& E, int wv) {
    pg8::Gemm g; g.A = A; g.Bt = Bt; g.M = S_; g.N = N; g.K = K;
    pg8::StaticOrder S; S.init(S_, N, (int)gridDim.x, (int)blockIdx.x);
    pg8::gemm_phase<Epi, pg8::StaticOrder, false>(lds, g, S, E, nullptr, wv);
}

__device__ __forceinline__ void tr_item(const float* W, int ldw, int k0, int scol0, const float* scale, bf16_t* WT, int K, int drow0, LAS float* scr, int lane) {
    float v[32];
    const float* wp = W + (size_t)(k0 + (lane >> 5)) * ldw + scol0 + (lane & 31);
#pragma unroll
    for (int i = 0; i < 32; ++i) v[i] = wp[(size_t)(2 * i) * ldw];
    if (scale) {
#pragma unroll
        for (int i = 0; i < 32; ++i) v[i] *= scale[k0 + 2 * i + (lane >> 5)]; }
#pragma unroll
    for (int i = 0; i < 32; ++i) scr[(2 * i + (lane >> 5)) * 33 + (lane & 31)] = v[i];
    asm volatile("s_waitcnt lgkmcnt(0)" ::: "memory");
    const int c = lane & 7;
#pragma unroll
    for (int j = 0; j < 4; ++j) { const int n = (lane >> 3) + 8 * j; const LAS float* s = scr + (8 * c) * 33 + n;
        u32x4 o; o.x = cvt_pk_bf16(s[0 * 33], s[1 * 33]); o.y = cvt_pk_bf16(s[2 * 33], s[3 * 33]); o.z = cvt_pk_bf16(s[4 * 33], s[5 * 33]); o.w = cvt_pk_bf16(s[6 * 33], s[7 * 33]);
        *(u32x4*)(WT + (size_t)(drow0 + n) * K + k0 + 8 * c) = o; }
    asm volatile("s_waitcnt lgkmcnt(0)" ::: "memory");
}

__device__ __forceinline__ void rs_phase(const Params& p, int wv) {
    const float* ss = (const float*)(p.ws + WS_SS); float* rsp = (float*)(p.ws + WS_RS);
    for (int t = bid_opaque() * 512 + fresh_tid(wv); t < S_ * 8; t += gridDim.x * 512) {
        const int row = t >> 3, part = t & 7; const float* q = ss + (size_t)row * 16 + 2 * part;
        float v = q[0] + q[1]; v += __shfl_xor(v, 1); v += __shfl_xor(v, 2); v += __shfl_xor(v, 4);
        if (part == 0) rsp[rs_index(row)] = rsqrtf(v * (1.0f / D_) + EPS_);
    }
}
__device__ __forceinline__ void prep_items(const Params& p, int layer, LAS unsigned char* lds, int wv, int lo, int hi, int rank, int nranks) {
    const int lane = fresh_tid(wv) & 63, wave = fresh_tid(wv) >> 6;
    LAS float* scr = (LAS float*)(lds + wave * 8448);
    unsigned char* wsw = p.ws + wofs(layer);
    const bool ssd = !(layer & 1); const int j = layer >> 1;
    const float* nw = p.norm_w + (size_t)layer * 3 * D_;
    constexpr int I_GU = (D_ / 64) * (FF_ / 32), I_D = (FF_ / 64) * (D_ / 32);
    const int nbin = ssd ? INSRC_ / 32 : CONVD_ / 32, I_MIN = (D_ / 64) * nbin, kout = ssd ? DI_ : D_, I_MOUT = (kout / 64) * (D_ / 32);
    const int total = 4 * I_GU + 2 * I_D + I_MIN + I_MOUT; if (hi > total) hi = total;
    for (int it = lo + rank; it < hi; it += nranks) {
        int r = it;
        if (r < 4 * I_GU) { const int which = r / I_GU; r -= which * I_GU; const int f = which >> 1, s = which & 1;
            const float* W = (s ? p.wu : p.wg) + (size_t)(layer * 2 + f) * D_ * FF_;
            const int kb = r / (FF_ / 32), nb = r - kb * (FF_ / 32), h0 = nb * 32, drow0 = 256 * (h0 >> 7) + 128 * s + (h0 & 127);
            tr_item(W, FF_, kb * 64, h0, nw + (f ? 2 * D_ : 0), (bf16_t*)(wsw + (f ? WS_GU2 : WS_GU1)), D_, drow0, scr, lane); continue; }
        r -= 4 * I_GU;
        if (r < 2 * I_D) { const int f = r / I_D; r -= f * I_D;
            const float* W = p.wd + (size_t)(layer * 2 + f) * FF_ * D_;
            const int kb = r / (D_ / 32), nb = r - kb * (D_ / 32);
            tr_item(W, D_, kb * 64, nb * 32, nullptr, (bf16_t*)(wsw + (f ? WS_D2 : WS_D1)), FF_, nb * 32, scr, lane); continue; }
        r -= 2 * I_D;
        if (r < I_MIN) { const int kb = r / nbin, nb = r - kb * nbin;
            const float* W = ssd ? p.ssd_w_in + (size_t)j * D_ * INSRC_ : p.sc_w_in + (size_t)j * D_ * CONVD_;
            tr_item(W, ssd ? INSRC_ : CONVD_, kb * 64, nb * 32, nw + D_, (bf16_t*)(wsw + WS_MIN), D_, nb * 32, scr, lane); continue; }
        r -= I_MIN;
        { const int kb = r / (D_ / 32), nb = r - kb * (D_ / 32);
            const float* W = ssd ? p.ssd_w_out + (size_t)j * DI_ * D_ : p.sc_w_out + (size_t)j * D_ * D_;
            tr_item(W, D_, kb * 64, nb * 32, nullptr, (bf16_t*)(wsw + WS_MOUT), kout, nb * 32, scr, lane); }
    }
}
__host__ __device__ inline int gu_tail_first(int G) { const int nwg = (S_ / 256) * (2 * FF_ / 256), r = nwg % G; return r == 0 ? G : r; }
__device__ __forceinline__ void prep_phase(const Params& p, int layer, LAS unsigned char* lds, int wv) {
    const int lane = fresh_tid(wv) & 63, wave = fresh_tid(wv) >> 6;
    const int gw = bid_opaque() * 8 + wave, NGW = gridDim.x * 8;
    const bool tails = layer > 0 && gu_tail_first((int)gridDim.x) < (int)gridDim.x;
    prep_items(p, layer, lds, wv, tails ? PREP_N2 : 0, 1 << 30, gw, NGW);
    if (layer == 0) {
        bf16_t* xb = (bf16_t*)(p.ws + WS_XB); float* ss = (float*)(p.ws + WS_SS);
        for (int row = gw; row < S_; row += NGW) {
            const f32x4* xr = (const f32x4*)(p.x + (size_t)row * D_) + lane;
            unsigned long long* o8 = (unsigned long long*)(xb + (size_t)row * D_) + lane; float s = 0.f;
#pragma unroll
            for (int q = 0; q < 4; ++q) { const f32x4 v = xr[64 * q]; s += (v.x * v.x + v.y * v.y) + (v.z * v.z + v.w * v.w);
                o8[64 * q] = (unsigned long long)cvt_pk_bf16(v.x, v.y) | ((unsigned long long)cvt_pk_bf16(v.z, v.w) << 32); }
            s = wave_sum(s);
            if (lane < 16) ss[(size_t)row * 16 + lane] = lane == 0 ? s : 0.f;
            if (lane == 0) ((float*)(p.ws + WS_RS))[rs_index(row)] = rsqrtf(s * (1.0f / D_) + EPS_);
        }
    } else rs_phase(p, wv);
}

__device__ __forceinline__ u32x4 pack8(const float (&f)[8]) { u32x4 w; w.x = cvt_pk_bf16(f[0], f[1]); w.y = cvt_pk_bf16(f[2], f[3]); w.z = cvt_pk_bf16(f[4], f[5]); w.w = cvt_pk_bf16(f[6], f[7]); return w; }

__device__ __forceinline__ void sc_conv_phase(const Params& p, int j, int wv) {
    const bf16_t* bcu = (const bf16_t*)(p.ws + WS_R2); bf16_t* vo = (bf16_t*)(p.ws + WS_R1); const float* cw = p.sc_conv_w + (size_t)j * 3 * D_;
    const int nthr = gridDim.x * 512;
    for (int idx = bid_opaque() * 512 + fresh_tid(wv); idx < (S_ / 16) * 128; idx += nthr) {
        const int tb = idx >> 7, c = (idx & 127) * 8, t0 = tb * 16;
        float w[3][8];
#pragma unroll
        for (int k = 0; k < 3; ++k) { const f32x4 w0 = *(const f32x4*)(cw + k * D_ + c), w1 = *(const f32x4*)(cw + k * D_ + c + 4);
#pragma unroll
            for (int e = 0; e < 4; ++e) { w[k][e] = w0[e]; w[k][4 + e] = w1[e]; } }
        float h0[8], h1[8];
#pragma unroll
        for (int e = 0; e < 8; ++e) { h0[e] = 0.f; h1[e] = 0.f; }
        if (t0 > 0) { float a[8], b[8];
            unpack8(*(const u32x4*)(bcu + (size_t)(t0 - 2) * CONVD_ + D_ + c), a); unpack8(*(const u32x4*)(bcu + (size_t)(t0 - 2) * CONVD_ + 2 * D_ + c), b);
#pragma unroll
            for (int e = 0; e < 8; ++e) h0[e] = a[e] * b[e];
            unpack8(*(const u32x4*)(bcu + (size_t)(t0 - 1) * CONVD_ + D_ + c), a); unpack8(*(const u32x4*)(bcu + (size_t)(t0 - 1) * CONVD_ + 2 * D_ + c), b);
#pragma unroll
            for (int e = 0; e < 8; ++e) h1[e] = a[e] * b[e]; }
        const bf16_t* row = bcu + (size_t)t0 * CONVD_ + c; bf16_t* orow = vo + (size_t)t0 * D_ + c;
#pragma unroll 8
        for (int r = 0; r < 16; ++r) {
            float bg[8], cgv[8], uv[8], o[8];
            unpack8(*(const u32x4*)(row + (size_t)r * CONVD_), bg); unpack8(*(const u32x4*)(row + (size_t)r * CONVD_ + D_), cgv); unpack8(*(const u32x4*)(row + (size_t)r * CONVD_ + 2 * D_), uv);
#pragma unroll
            for (int e = 0; e < 8; ++e) { const float cu = cgv[e] * uv[e]; o[e] = bg[e] * (w[0][e] * h0[e] + w[1][e] * h1[e] + w[2][e] * cu); h0[e] = h1[e]; h1[e] = cu; }
            *(u32x4*)(orow + (size_t)r * D_) = pack8(o);
        }
    }
}
__device__ __forceinline__ void ssd_conv_phase(const Params& p, int j, int wv) {
    const bf16_t* raw = (const bf16_t*)(p.ws + WS_R2); bf16_t* xo = (bf16_t*)(p.ws + WS_R3);
    const float* cw = p.ssd_conv_w + (size_t)j * 4 * CONVD_; const float* cb = p.ssd_conv_b + (size_t)j * CONVD_;
    const int nthr = gridDim.x * 512;
    for (int idx = bid_opaque() * 512 + fresh_tid(wv); idx < (S_ / 64) * 384; idx += nthr) {
        const int tb = idx / 384, c = (idx - tb * 384) * 8, t0 = tb * 64;
        float w[4][8], bias[8];
#pragma unroll
        for (int k = 0; k < 4; ++k) { const f32x4 w0 = *(const f32x4*)(cw + k * CONVD_ + c), w1 = *(const f32x4*)(cw + k * CONVD_ + c + 4);
#pragma unroll
            for (int e = 0; e < 4; ++e) { w[k][e] = w0[e]; w[k][4 + e] = w1[e]; } }
        { const f32x4 b0 = *(const f32x4*)(cb + c), b1 = *(const f32x4*)(cb + c + 4);
#pragma unroll
          for (int e = 0; e < 4; ++e) { bias[e] = b0[e]; bias[4 + e] = b1[e]; } }
        float h0[8], h1[8], h2[8];
#pragma unroll
        for (int e = 0; e < 8; ++e) { h0[e] = 0.f; h1[e] = 0.f; h2[e] = 0.f; }
        if (t0 > 0) { unpack8(*(const u32x4*)(raw + (size_t)(t0 - 3) * CONVD_ + c), h0); unpack8(*(const u32x4*)(raw + (size_t)(t0 - 2) * CONVD_ + c), h1); unpack8(*(const u32x4*)(raw + (size_t)(t0 - 1) * CONVD_ + c), h2); }
        const bf16_t* row = raw + (size_t)t0 * CONVD_ + c; bf16_t* orow = xo + (size_t)t0 * CONVD_ + c;
#pragma unroll 8
        for (int r = 0; r < 64; ++r) {
            float v[8], o[8]; unpack8(*(const u32x4*)(row + (size_t)r * CONVD_), v);
#pragma unroll
            for (int e = 0; e < 8; ++e) { o[e] = silu_f(bias[e] + w[0][e] * h0[e] + w[1][e] * h1[e] + w[2][e] * h2[e] + w[3][e] * v[e]); h0[e] = h1[e]; h1[e] = h2[e]; h2[e] = v[e]; }
            *(u32x4*)(orow + (size_t)r * CONVD_) = pack8(o);
        }
    }
}
__device__ __forceinline__ void ssd_dt_phase(const Params& p, int j, int wv) {
    const int tid = fresh_tid(wv), lane = tid & 63, wave = tid >> 6, fr = lane & 15, fq = lane >> 4;
    const bf16_t* xb = (const bf16_t*)(p.ws + WS_XB); const bf16_t* wdt = (const bf16_t*)(p.ws + wofs(2 * j) + WS_MIN) + (size_t)5120 * D_; const float* ss = (const float*)(p.ws + WS_SS); float* dt = (float*)(p.ws + WS_DT);
    const float* bias = p.ssd_dt_bias + j * NH_;
    for (int tile = bid_opaque() * 8 + wave; tile < S_ / 16; tile += gridDim.x * 8) {
        const int r0 = tile * 16;
        const bf16_t* ap = xb + (size_t)(r0 + fr) * D_ + 8 * fq; const bf16_t* bp = wdt + (size_t)fr * D_ + 8 * fq;
        f32x4 acc0 = (f32x4){0.f, 0.f, 0.f, 0.f}, acc1 = acc0;
#pragma unroll 8
        for (int ks = 0; ks < 32; ++ks) {
            const pg8::bf16x8 a = *(const pg8::bf16x8*)(ap + ks * 32), b0 = *(const pg8::bf16x8*)(bp + ks * 32), b1 = *(const pg8::bf16x8*)(bp + 16 * D_ + ks * 32);
            acc0 = __builtin_amdgcn_mfma_f32_16x16x32_bf16(b0, a, acc0, 0, 0, 0); acc1 = __builtin_amdgcn_mfma_f32_16x16x32_bf16(b1, a, acc1, 0, 0, 0);
        }
        const float rs = ((const float*)(p.ws + WS_RS))[rs_index(r0 + fr)];
        const f32x4 bb0 = *(const f32x4*)(bias + 4 * fq), bb1 = *(const f32x4*)(bias + 16 + 4 * fq);
        f32x4 a = acc0 * rs + bb0, b = acc1 * rs + bb1;
#pragma unroll
        for (int e = 0; e < 4; ++e) { a[e] = fmaxf(a[e], 0.f) + log1pf(__expf(-fabsf(a[e]))); b[e] = fmaxf(b[e], 0.f) + log1pf(__expf(-fabsf(b[e]))); }
        float* o = dt + (size_t)(r0 + fr) * 32 + 4 * fq; *(f32x4*)o = a; *(f32x4*)(o + 16) = b;
    }
}
__device__ __forceinline__ void ssd_acs_phase(const Params& p, int j, int wv) {
    const float* dt = (const float*)(p.ws + WS_DT); float* acsT = (float*)(p.ws + WS_ACS); float* dtT = (float*)(p.ws + WS_DTT);
    const int tid = fresh_tid(wv), lane = tid & 63, wave = tid >> 6;
    for (int it = bid_opaque() * 8 + wave; it < 128 * NH_; it += gridDim.x * 8) {
        const int c = it >> 5, h = it & 31; const float a = -__expf(p.ssd_a_log[j * NH_ + h]);
        const size_t t0 = (size_t)c * 128 + 2 * lane; const float d0 = dt[t0 * 32 + h], d1 = dt[(t0 + 1) * 32 + h];
        const float v0 = d0 * a, v1 = d1 * a; float s = v0 + v1;
#pragma unroll
        for (int o = 1; o < 64; o <<= 1) { const float t = __shfl_up(s, o); if (lane >= o) s += t; }
        const float ex = s - (v0 + v1); const size_t o = (size_t)it * 128 + 2 * lane;
        acsT[o] = ex + v0; acsT[o + 1] = ex + v0 + v1; dtT[o] = d0; dtT[o + 1] = d1;
    }
}
typedef short s16x4 __attribute__((ext_vector_type(4)));
__device__ __forceinline__ pg8::bf16x8 tr8(LAS unsigned char* lane_base, int off, int stride) {
    const s16x4 lo = __builtin_amdgcn_ds_read_tr16_b64_v4i16((LAS s16x4*)(lane_base + off));
    const s16x4 hi = __builtin_amdgcn_ds_read_tr16_b64_v4i16((LAS s16x4*)(lane_base + off + 4 * stride));
    pg8::bf16x8 r; r[0] = lo[0]; r[1] = lo[1]; r[2] = lo[2]; r[3] = lo[3]; r[4] = hi[0]; r[5] = hi[1]; r[6] = hi[2]; r[7] = hi[3]; return r;
}
__device__ __forceinline__ unsigned long long pack4(const f32x4 v) { return (unsigned long long)cvt_pk_bf16(v.x, v.y) | ((unsigned long long)cvt_pk_bf16(v.z, v.w) << 32); }
constexpr int XS_STRIDE = 1056, BS_STRIDE = 160, CS_STRIDE = 272;
__device__ __forceinline__ void ssd_states_phase(const Params& p, LAS unsigned char* lds, int wv) {
    const int tid = fresh_tid(wv), lane = tid & 63, wave = tid >> 6, fr = lane & 15, fq = lane >> 4;
    const bf16_t* xc = (const bf16_t*)(p.ws + WS_R3); const float* acsT = (const float*)(p.ws + WS_ACS); const float* dtT = (const float*)(p.ws + WS_DTT); bf16_t* st = (bf16_t*)(p.ws + WS_ST);
    LAS unsigned char* Xs = lds; LAS unsigned char* Bs = lds + 64 * XS_STRIDE; LAS float* wt = (LAS float*)(lds + 64 * XS_STRIDE + 64 * BS_STRIDE);
    LAS unsigned char* trB = Bs + (8 * fq + (fr >> 2)) * BS_STRIDE + 8 * (lane & 3);
    LAS unsigned char* trX = Xs + (8 * fq + (fr >> 2)) * XS_STRIDE + 8 * (lane & 3) + wave * 128;
#pragma unroll 1
    for (int it = bid_opaque(); it < 1024; it += gridDim.x) {
        const int item = 2 * (it % 512) + it / 512 * 0 + ((it >= 512) ? 1 : 0);
        const int c = item >> 3, g = (item >> 1) & 3, nh = item & 1;
        __syncthreads();
        for (int i = tid; i < 1024; i += 512) { const int e = i >> 7, l = i & 127; const size_t o = (size_t)(c * 32 + g * 8 + e) * 128; wt[i] = dtT[o + l] * __expf(acsT[o + 127] - acsT[o + l]); }
        f32x4 acc[4][4];
#pragma unroll
        for (int a = 0; a < 4; ++a)
#pragma unroll
            for (int b = 0; b < 4; ++b) acc[a][b] = (f32x4){0.f, 0.f, 0.f, 0.f};
#pragma unroll 1
        for (int half = 0; half < 2; ++half) {
            __syncthreads();
            {
                const int ch = tid & 63, r0 = tid >> 6;
                const bf16_t* xsrc = xc + (size_t)(c * 128 + half * 64 + r0) * CONVD_ + g * 512 + ch * 8;
                u32x4 v[8];
#pragma unroll
                for (int u = 0; u < 8; ++u) v[u] = *(const u32x4*)(xsrc + (size_t)u * 8 * CONVD_);
                const int rb = tid >> 3, cb8 = tid & 7;
                const u32x4 bv = *(const u32x4*)(xc + (size_t)(c * 128 + half * 64 + rb) * CONVD_ + DI_ + g * 128 + nh * 64 + cb8 * 8);
#pragma unroll
                for (int u = 0; u < 8; ++u) { float f[8]; unpack8(v[u], f); const float w = wt[(ch >> 3) * 128 + half * 64 + r0 + 8 * u];
#pragma unroll
                    for (int e = 0; e < 8; ++e) f[e] *= w;
                    *(LAS u32x4*)(Xs + (r0 + 8 * u) * XS_STRIDE + ch * 16) = pack8(f); }
                *(LAS u32x4*)(Bs + rb * BS_STRIDE + cb8 * 16) = bv;
            }
            __syncthreads();
#pragma unroll
            for (int ks = 0; ks < 2; ++ks) {
                pg8::bf16x8 ap[4];
#pragma unroll
                for (int pt = 0; pt < 4; ++pt) ap[pt] = tr8(trX, ks * 32 * XS_STRIDE + pt * 32, XS_STRIDE);
#pragma unroll
                for (int nt = 0; nt < 4; ++nt) { const pg8::bf16x8 bn = tr8(trB, ks * 32 * BS_STRIDE + nt * 32, BS_STRIDE);
#pragma unroll
                    for (int pt = 0; pt < 4; ++pt) acc[pt][nt] = __builtin_amdgcn_mfma_f32_16x16x32_bf16(bn, ap[pt], acc[pt][nt], 0, 0, 0); }
            }
        }
        bf16_t* so = st + (size_t)(c * 32 + g * 8 + wave) * 64 * 128 + fr * 128 + nh * 64 + 4 * fq;
#pragma unroll
        for (int pt = 0; pt < 4; ++pt)
#pragma unroll
            for (int nt = 0; nt < 4; ++nt) *(unsigned long long*)(so + pt * 16 * 128 + nt * 16) = pack4(acc[pt][nt]);
    }
}
__device__ __forceinline__ void ssd_cscan_phase(const Params& p, int wv) {
    const float* acsT = (const float*)(p.ws + WS_ACS); bf16_t* st = (bf16_t*)(p.ws + WS_ST);
    for (int e2 = bid_opaque() * 512 + fresh_tid(wv); e2 < NH_ * 4096; e2 += gridDim.x * 512) {
        const int h = e2 >> 12, rem = e2 & 4095; float r0 = 0.f, r1 = 0.f;
#pragma unroll 8
        for (int c = 0; c < 128; ++c) {
            unsigned* ptr = (unsigned*)(st + (size_t)(c * 32 + h) * 8192 + 2 * rem); const unsigned v = *ptr; const float d = __expf(acsT[(size_t)(c * 32 + h) * 128 + 127]);
            *ptr = cvt_pk_bf16(r0, r1); r0 = d * r0 + bflo(v); r1 = d * r1 + bfhi(v);
        }
    }
}
__device__ __forceinline__ void ssd_yout_phase(const Params& p, int j, LAS unsigned char* lds, int wv) {
    const int tid = fresh_tid(wv), lane = tid & 63, wave = tid >> 6, fr = lane & 15, fq = lane >> 4;
    const bf16_t* xc = (const bf16_t*)(p.ws + WS_R3); const float* acsT = (const float*)(p.ws + WS_ACS); const float* dtT = (const float*)(p.ws + WS_DTT);
    const bf16_t* st = (const bf16_t*)(p.ws + WS_ST); bf16_t* zg = (bf16_t*)(p.ws + WS_R1); const float* nw = p.ssd_norm_w + (size_t)j * DI_;
    LAS unsigned char* Cs = lds; LAS unsigned char* CBs = lds + 64 * CS_STRIDE; LAS unsigned char* Xs = lds + 128 * CS_STRIDE; LAS unsigned char* Bs = Xs;
    LAS float* acs_t = (LAS float*)(lds + 128 * CS_STRIDE + 64 * XS_STRIDE); LAS float* dt_t = acs_t + 1024; LAS float* red = dt_t + 1024;
    LAS unsigned char* cfb = Cs + fr * CS_STRIDE + 16 * fq;
    LAS unsigned char* bfb = Bs + fr * CS_STRIDE + 16 * fq;
    LAS unsigned char* cbr = CBs + fr * CS_STRIDE + 16 * fq;
    LAS unsigned char* trX = Xs + (8 * fq + (fr >> 2)) * XS_STRIDE + 8 * (lane & 3) + wave * 128;
    LAS float* redw = red + fr * 8;
#pragma unroll 1
    for (int it = bid_opaque(); it < 1024; it += gridDim.x) {
        const int item = 2 * (it % 512) + ((it >= 512) ? 1 : 0);
        const int c = item >> 3, g = (item >> 1) & 3, lh = item & 1, h = g * 8 + wave; const size_t trow = (size_t)c * 128; const int lbase = 64 * lh;
        LAS float* acl = acs_t + wave * 128 + lbase + fr;
        LAS float* acq = acs_t + wave * 128 + 8 * fq;
        __syncthreads();
        {
            const int r = tid >> 4, ch = tid & 15;
            const bf16_t* bsrc = xc + (trow + r) * CONVD_ + DI_ + g * 128 + ch * 8; const bf16_t* csrc = xc + (trow + lbase + r) * CONVD_ + DI_ + 512 + g * 128 + ch * 8;
            const size_t o = (size_t)(c * 32 + g * 8) * 128 + tid;
            u32x4 bv[4], cv[2];
#pragma unroll
            for (int u = 0; u < 4; ++u) bv[u] = (u < 2 || lh) ? *(const u32x4*)(bsrc + (size_t)u * 32 * CONVD_) : (u32x4){0u, 0u, 0u, 0u};
#pragma unroll
            for (int u = 0; u < 2; ++u) cv[u] = *(const u32x4*)(csrc + (size_t)u * 32 * CONVD_);
            const float a0 = acsT[o], a1 = acsT[o + 512], d0 = dtT[o], d1 = dtT[o + 512];
#pragma unroll
            for (int u = 0; u < 4; ++u) *(LAS u32x4*)(Bs + (r + 32 * u) * CS_STRIDE + ch * 16) = bv[u];
#pragma unroll
            for (int u = 0; u < 2; ++u) *(LAS u32x4*)(Cs + (r + 32 * u) * CS_STRIDE + ch * 16) = cv[u];
            acs_t[tid] = a0; acs_t[tid + 512] = a1; dt_t[tid] = d0; dt_t[tid + 512] = d1;
        }
        __syncthreads();
        {
            const int lt = wave & 3, sg = wave >> 2, mt = 4 * lh + lt;
            pg8::bf16x8 cf[4];
#pragma unroll
            for (int ks = 0; ks < 4; ++ks) cf[ks] = *(const LAS pg8::bf16x8*)(cfb + lt * 16 * CS_STRIDE + ks * 64);
#pragma unroll
            for (int si = 0; si < 4; ++si) {
                const int s8 = 4 * sg + si;
                if (s8 <= (mt | 1)) {
                    f32x4 a = (f32x4){0.f, 0.f, 0.f, 0.f};
#pragma unroll
                    for (int ks = 0; ks < 4; ++ks) { const pg8::bf16x8 bf = *(const LAS pg8::bf16x8*)(bfb + s8 * 16 * CS_STRIDE + ks * 64); a = __builtin_amdgcn_mfma_f32_16x16x32_bf16(bf, cf[ks], a, 0, 0, 0); }
                    *(LAS unsigned long long*)(CBs + (lt * 16 + fr) * CS_STRIDE + (s8 * 16 + 4 * fq) * 2) = pack4(a);
                }
            }
        }
        f32x4 acc[4][4];
#pragma unroll
        for (int a = 0; a < 4; ++a)
#pragma unroll
            for (int b = 0; b < 4; ++b) acc[a][b] = (f32x4){0.f, 0.f, 0.f, 0.f};
        {
            const bf16_t* pv = st + (size_t)(c * 32 + h) * 8192 + fr * 128 + 8 * fq;
#pragma unroll
            for (int ks = 0; ks < 4; ++ks) {
                pg8::bf16x8 pf[4];
#pragma unroll
                for (int pt = 0; pt < 4; ++pt) pf[pt] = *(const pg8::bf16x8*)(pv + pt * 16 * 128 + ks * 32);
#pragma unroll
                for (int lt = 0; lt < 4; ++lt) { const pg8::bf16x8 cf = *(const LAS pg8::bf16x8*)(cfb + lt * 16 * CS_STRIDE + ks * 64);
#pragma unroll
                    for (int pt = 0; pt < 4; ++pt) acc[lt][pt] = __builtin_amdgcn_mfma_f32_16x16x32_bf16(pf[pt], cf, acc[lt][pt], 0, 0, 0); }
            }
#pragma unroll
            for (int lt = 0; lt < 4; ++lt) { const float sc = __expf(acl[lt * 16]);
#pragma unroll
                for (int pt = 0; pt < 4; ++pt) acc[lt][pt] = acc[lt][pt] * sc; }
        }
#pragma unroll 1
        for (int half = 0; half <= lh; ++half) {
            __syncthreads();
            {
                const int ch = tid & 63, r0 = tid >> 6;
                const bf16_t* xsrc = xc + (trow + half * 64 + r0) * CONVD_ + g * 512 + ch * 8;
                u32x4 v[8];
#pragma unroll
                for (int u = 0; u < 8; ++u) v[u] = *(const u32x4*)(xsrc + (size_t)u * 8 * CONVD_);
#pragma unroll
                for (int u = 0; u < 8; ++u) { float f[8]; unpack8(v[u], f); const float w = dt_t[(ch >> 3) * 128 + half * 64 + r0 + 8 * u];
#pragma unroll
                    for (int e = 0; e < 8; ++e) f[e] *= w;
                    *(LAS u32x4*)(Xs + (r0 + 8 * u) * XS_STRIDE + ch * 16) = pack8(f); }
            }
            __syncthreads();
#pragma unroll
            for (int kk = 0; kk < 2; ++kk) {
                const int kt = 2 * half + kk;
                pg8::bf16x8 xf[4];
#pragma unroll
                for (int pt = 0; pt < 4; ++pt) xf[pt] = tr8(trX, kk * 32 * XS_STRIDE + pt * 32, XS_STRIDE);
                const f32x4 as0 = *(const LAS f32x4*)(acq + kt * 32), as1 = *(const LAS f32x4*)(acq + kt * 32 + 4);
                const float asv[8] = {as0.x, as0.y, as0.z, as0.w, as1.x, as1.y, as1.z, as1.w};
#pragma unroll
                for (int lt = 0; lt < 4; ++lt) {
                    const int mt = 4 * lh + lt;
                    if (mt >= 2 * kt) {
                        const int dl = mt * 16 + fr - kt * 32 - 8 * fq;
                        const float al = acl[lt * 16];
                        float cb[8]; unpack8(*(const LAS u32x4*)(cbr + lt * 16 * CS_STRIDE + kt * 64), cb);
#pragma unroll
                        for (int e = 0; e < 8; ++e) cb[e] = (e <= dl) ? cb[e] * __expf(fminf(al - asv[e], 0.f)) : 0.f;
                        const u32x4 pw = pack8(cb); const pg8::bf16x8 pfr = __builtin_bit_cast(pg8::bf16x8, pw);
#pragma unroll
                        for (int pt = 0; pt < 4; ++pt) acc[lt][pt] = __builtin_amdgcn_mfma_f32_16x16x32_bf16(xf[pt], pfr, acc[lt][pt], 0, 0, 0);
                    }
                }
            }
        }
        const float Dh = p.ssd_d[j * NH_ + h];
        const bf16_t* xrow = xc + (trow + lbase + fr) * CONVD_ + h * 64 + 4 * fq; bf16_t* zrow = zg + (trow + lbase + fr) * DI_ + h * 64 + 4 * fq;
#pragma unroll
        for (int lt = 0; lt < 4; ++lt) {
            float q = 0.f;
#pragma unroll
            for (int pt = 0; pt < 4; ++pt) {
                const unsigned long long xv = *(const unsigned long long*)(xrow + (size_t)lt * 16 * CONVD_ + pt * 16), zv = *(const unsigned long long*)(zrow + (size_t)lt * 16 * DI_ + pt * 16);
                const float x4[4] = {bflo((unsigned)xv), bfhi((unsigned)xv), bflo((unsigned)(xv >> 32)), bfhi((unsigned)(xv >> 32))};
                const float z4[4] = {bflo((unsigned)zv), bfhi((unsigned)zv), bflo((unsigned)(zv >> 32)), bfhi((unsigned)(zv >> 32))};
#pragma unroll
                for (int e = 0; e < 4; ++e) { const float y = (acc[lt][pt][e] + Dh * x4[e]) * silu_f(z4[e]); acc[lt][pt][e] = y; q += y * y; }
            }
            q += __shfl_xor(q, 16); q += __shfl_xor(q, 32);
            if (fq == 0) redw[lt * 128 + wave] = q;
        }
        __syncthreads();
        const float* nwl = nw + h * 64 + 4 * fq;
#pragma unroll
        for (int lt = 0; lt < 4; ++lt) {
            const f32x4 r0 = *(const LAS f32x4*)(redw + lt * 128), r1 = *(const LAS f32x4*)(redw + lt * 128 + 4);
            const float rs = rsqrtf((((r0.x + r0.y) + (r0.z + r0.w)) + ((r1.x + r1.y) + (r1.z + r1.w))) * (1.0f / 512.f) + EPS_);
#pragma unroll
            for (int pt = 0; pt < 4; ++pt) { const f32x4 w = *(const f32x4*)(nwl + pt * 16);
                *(unsigned long long*)(zrow + (size_t)lt * 16 * DI_ + pt * 16) = pack4(acc[lt][pt] * rs * w); }
        }
    }
}
__device__ __forceinline__ void final_phase(const Params& p, int wv) {
    const int tid = fresh_tid(wv), lane = tid & 63, wave = tid >> 6; const bf16_t* xb = (const bf16_t*)(p.ws + WS_XB);
    for (int row = bid_opaque() * 8 + wave; row < S_; row += gridDim.x * 8) {
        const u32x4* xr = (const u32x4*)(xb + (size_t)row * D_) + lane; f32x4* orow = (f32x4*)(p.out + (size_t)row * D_) + 2 * lane; const f32x4* wr = (const f32x4*)p.final_w + 2 * lane;
        float v[2][8]; float s = 0.f;
#pragma unroll
        for (int q = 0; q < 2; ++q) { unpack8(xr[64 * q], v[q]);
#pragma unroll
            for (int e = 0; e < 8; ++e) s += v[q][e] * v[q][e]; }
        const float rs = rsqrtf(wave_sum(s) * (1.0f / D_) + EPS_);
#pragma unroll
        for (int q = 0; q < 2; ++q) { const f32x4 w0 = wr[128 * q], w1 = wr[128 * q + 1];
            orow[128 * q] = (f32x4){v[q][0], v[q][1], v[q][2], v[q][3]} * rs * w0; orow[128 * q + 1] = (f32x4){v[q][4], v[q][5], v[q][6], v[q][7]} * rs * w1; }
    }
}

__host__ __device__ inline bool phase_active(int ph) { if (ph >= NPH - 1) return ph == NPH - 1; const int layer = ph / NSLOT, k = ph % NSLOT; return !((layer & 1) && (k >= 5 && k <= 7)); }

__device__ __forceinline__ void run_phase(const Params& p, int ph, LAS unsigned char* lds, int wv) {
    if (ph == NPH - 1) { final_phase(p, wv); return; }
    const int layer = ph / NSLOT, k = ph - layer * NSLOT, j = layer >> 1; const bool ssd = !(layer & 1);
    bf16_t* xb = (bf16_t*)(p.ws + WS_XB); float* ss = (float*)(p.ws + WS_SS);
    const int kk = k;
    EpiAll E{}; E.ss = ss; E.rsp = (const float*)(p.ws + WS_RS); E.x = p.out; E.dt = (float*)(p.ws + WS_DT); E.dt_bias = p.ssd_dt_bias + j * NH_; E.dt_tile = -1; E.scale = 1.0f;
    const bf16_t* A = xb; const bf16_t* Bt = nullptr; int N = 0, K = D_; bool gemm = true;
    switch (kk) {
    case 1: case 9: E.mode = 0; E.o0 = (bf16_t*)(p.ws + WS_R1); E.ld0 = FF_; Bt = (const bf16_t*)(p.ws + wofs(layer) + (kk == 1 ? WS_GU1 : WS_GU2)); N = 2 * FF_; break;
    case 2: case 10: E.mode = 1; E.o0 = xb; E.scale = 0.5f; A = (const bf16_t*)(p.ws + WS_R1); Bt = (const bf16_t*)(p.ws + wofs(layer) + (kk == 2 ? WS_D1 : WS_D2)); N = D_; K = FF_; break;
    case 3: E.mode = 2; Bt = (const bf16_t*)(p.ws + wofs(layer) + WS_MIN);
            if (ssd) { E.o0 = (bf16_t*)(p.ws + WS_R1); E.ld0 = DI_; E.nt0 = 8; E.o1 = (bf16_t*)(p.ws + WS_R2); E.ld1 = CONVD_; N = DI_ + CONVD_; }
            else { E.o0 = (bf16_t*)(p.ws + WS_R2); E.ld0 = CONVD_; E.nt0 = 12; E.o1 = E.o0; E.ld1 = CONVD_; N = CONVD_; } break;
    case 8: E.mode = 1; E.o0 = xb; A = (const bf16_t*)(p.ws + WS_R1); Bt = (const bf16_t*)(p.ws + wofs(layer) + WS_MOUT); N = D_; K = ssd ? DI_ : D_; break;
    default: gemm = false; break;
    }
    if (gemm) { run_gemm(lds, A, Bt, N, K, E, wv); if (kk == 3 && ssd) ssd_dt_phase(p, j, wv);
        if (E.mode == 0 && layer < 3) {
            const int G = (int)gridDim.x, first = gu_tail_first(G), c = bid_opaque();
            if (c >= first) prep_items(p, layer + 1, lds, wv, kk == 1 ? 0 : PREP_N1, kk == 1 ? PREP_N1 : PREP_N2, (c - first) * 8 + (fresh_tid(wv) >> 6), (G - first) * 8);
        }
        return; }
    switch (kk) {
    case 0: prep_phase(p, layer, lds, wv); break;
    case 4: if (ssd) { ssd_conv_phase(p, j, wv); ssd_acs_phase(p, j, wv); } else sc_conv_phase(p, j, wv); break;
    case 5: if (ssd) ssd_states_phase(p, lds, wv); break;
    case 6: if (ssd) ssd_cscan_phase(p, wv); break;
    case 7: if (ssd) ssd_yout_phase(p, j, lds, wv); break;
    }
}

__global__ __launch_bounds__(512, 2) void mega(Params p) {
    extern __shared__ __attribute__((aligned(16))) unsigned char shm[];
    LAS unsigned char* lds = (LAS unsigned char*)shm;
    cg::grid_group grid = cg::this_grid();
    const int wv = __builtin_amdgcn_readfirstlane((int)(threadIdx.x >> 6));
    const bool t0 = (threadIdx.x == 0);
    if (threadIdx.x < 16) ((LAS unsigned*)(lds + LDS_CTL))[threadIdx.x] = 0u;
    __syncthreads();
    XcdBarrier xb = xcd_barrier_post((unsigned*)(p.ws + WS_BAR), (volatile LAS unsigned*)(lds + LDS_CTL), t0);
    bool first = true;
    for (int ph = p.ph_lo; ph < p.ph_hi; ++ph) {
        if (!phase_active(ph)) continue;
        { const int k = ph % NSLOT; if (ph < NPH - 1 && (k == 3 || k == 9)) { rs_phase(p, wv); xcd_barrier(xb, fresh_tid(wv) == 0); } }
        run_phase(p, ph, lds, wv);
        if (ph + 1 < p.ph_hi) {
            if (first) { __syncthreads(); grid.sync(); first = false; }
            else xcd_barrier(xb, fresh_tid(wv) == 0);
        }
    }
}

extern "C" void kernel_launch(void* const* d_in, const int* in_sizes, int n_in, void* d_out, int out_size, void* d_ws, size_t ws_size, hipStream_t stream) {
    static int grid = 0;
    if (grid == 0) {
        int dev = 0, cus = 0, per_cu = 0;
        hipGetDevice(&dev); hipDeviceGetAttribute(&cus, hipDeviceAttributeMultiprocessorCount, dev);
        hipFuncSetAttribute((const void*)mega, hipFuncAttributeMaxDynamicSharedMemorySize, LDS_BYTES);
        hipOccupancyMaxActiveBlocksPerMultiprocessor(&per_cu, (const void*)mega, 512, LDS_BYTES);
        if (per_cu < 1) per_cu = 1;
        grid = cus * per_cu;
        if (ws_size < WS_END) fprintf(stderr, "kernel_launch: workspace too small: %zu < %zu\n", ws_size, (size_t)WS_END);
        (void)hipGetLastError();
    }
    (void)hipMemsetAsync((unsigned char*)d_ws + WS_BAR, 0, 16384, stream);
    Params p{};
    p.x = (const float*)d_in[0]; p.norm_w = (const float*)d_in[1]; p.wg = (const float*)d_in[2]; p.wu = (const float*)d_in[3]; p.wd = (const float*)d_in[4];
    p.ssd_w_in = (const float*)d_in[5]; p.ssd_conv_w = (const float*)d_in[6]; p.ssd_conv_b = (const float*)d_in[7]; p.ssd_dt_bias = (const float*)d_in[8];
    p.ssd_a_log = (const float*)d_in[9]; p.ssd_d = (const float*)d_in[10]; p.ssd_norm_w = (const float*)d_in[11]; p.ssd_w_out = (const float*)d_in[12];
    p.sc_w_in = (const float*)d_in[13]; p.sc_conv_w = (const float*)d_in[14]; p.sc_w_out = (const float*)d_in[15]; p.final_w = (const float*)d_in[16];
    p.out = (float*)d_out; p.ws = (unsigned char*)d_ws;
#if ONE_LAUNCH
    p.ph_lo = 0; p.ph_hi = NPH;
    void* args[] = {&p};
    hipError_t e = hipLaunchCooperativeKernel((const void*)mega, dim3(grid), dim3(512), args, LDS_BYTES, stream);
    if (e != hipSuccess) fprintf(stderr, "cooperative launch failed: %s (grid %d)\n", hipGetErrorString(e), grid);
#else
    for (int ph = 0; ph < NPH; ++ph) { if (!phase_active(ph)) continue; p.ph_lo = ph; p.ph_hi = ph + 1; hipLaunchKernelGGL(mega, dim3(grid), dim3(512), LDS_BYTES, stream, p); }
#endif
}
```

```cpp
#include <hip/hip_runtime.h>
#include <hip/hip_cooperative_groups.h>
#include <cstdio>
namespace cg = cooperative_groups;
#ifndef ONE_LAUNCH
#define ONE_LAUNCH 1
#endif
__device__ __forceinline__ int fresh_tid(int wv) { unsigned m = ~0u; asm volatile("" : "+s"(m)); const int lane = (int)__builtin_amdgcn_mbcnt_hi(m, __builtin_amdgcn_mbcnt_lo(m, 0u)); return wv * 64 + lane; }
__device__ __forceinline__ int bid_opaque() { int b = blockIdx.x; asm volatile("" : "+s"(b)); return b; }
namespace pg8 {
#define PG8_LAS __attribute__((address_space(3)))
typedef unsigned short bf16_t;
typedef short bf16x8 __attribute__((ext_vector_type(8)));
typedef float f32x4 __attribute__((ext_vector_type(4)));
typedef unsigned u32x4 __attribute__((ext_vector_type(4)));
constexpr int BM = 256, BK = 64, HALF = 128, HTB = HALF * BK * 2  , STAGE_BYTES = 8 * HTB, NXCD = 8, WGM = 8;

__host__ __device__ __forceinline__ int lds_byte(int r, int c) { const int st = (r >> 4) * 2 + (c >> 5), rr = r & 15, cc = c & 31, ob = rr * 64 + cc * 2; return st * 1024 + (ob ^ (((ob >> 9) & 1) << 5)); }
__host__ __device__ __forceinline__ void stage_rc(int b, int& R, int& C) { const int st = b / 1024, sb = b % 1024, swz = sb ^ (((sb >> 9) & 1) << 5); R = (st >> 1) * 16 + swz / 64; C = (st & 1) * 32 + (swz % 64) / 2; }
__host__ __device__ __forceinline__ int perm32(int rho) { const int n = rho >> 4, i = rho & 15; return 8 * (i >> 2) + 4 * n + (i & 3); }

struct Unit { int pm, pn; };
struct Gemm { const bf16_t* A; const bf16_t* Bt; int M, N, K; };
struct StaticOrder {
    int nM, nN, nwg, G, c;
    __host__ __device__ void init(int M, int N, int G_, int c_) { nM = M / BM; nN = N / BM; nwg = nM * nN; G = G_; c = c_; }
    __host__ __device__ bool next(int i, Unit& u) const {
        const long L = (long)i * G + c; if (L >= nwg) return false;
        int wgid = (int)L; { const int q = nwg / NXCD, r = nwg % NXCD, xcd = wgid % NXCD, off = wgid / NXCD; wgid = (xcd < r ? xcd * (q + 1) : r * (q + 1) + (xcd - r) * q) + off; }
        const int nig = WGM * nN, gid = wgid / nig, fm = gid * WGM, gsz = (nM - fm) < WGM ? (nM - fm) : WGM;
        u.pm = fm + ((wgid % nig) % gsz); u.pn = (wgid % nig) / gsz; return true;
    }
    __device__ __forceinline__ void a_ready(const Unit&) const {}
    __device__ __forceinline__ void done(const Unit&) const {}
};
typedef float f32x2_t __attribute__((ext_vector_type(2)));
typedef __bf16 bf16x2_t __attribute__((ext_vector_type(2)));
__device__ __forceinline__ unsigned cvt_pk_bf16(float lo, float hi) { const f32x2_t f = {lo, hi}; const bf16x2_t b = __builtin_convertvector(f, bf16x2_t); return __builtin_bit_cast(unsigned, b); }
template <class Epi, class Sched, bool STAMP = false>
__device__ __forceinline__ void gemm_phase(PG8_LAS unsigned char* lds, const Gemm g, const Sched& S, const Epi& E, unsigned long long* stamps, int wv) {
    const int tid = fresh_tid(wv), wid = __builtin_amdgcn_readfirstlane(tid >> 6), lane = tid & 63, wr = wid >> 2, wc = wid & 3, fr = lane & 15, fq = lane >> 4;
    const int K = g.K, nt = K / BK;
    int ts_lo = 0, ts_hi = 0, nts = 0; const unsigned long long rt_entry = STAMP ? (unsigned long long)wall_clock64() : 0ull;
#define PG8_STAMP() do { if (STAMP && wid == 0 && nts < 64) { const unsigned long long _c = (unsigned long long)clock64(); \
        ts_lo = (lane == nts) ? (int)(unsigned)_c : ts_lo; ts_hi = (lane == nts) ? (int)(unsigned)(_c >> 32) : ts_hi; ++nts; } } while (0)
    PG8_STAMP();
    unsigned voffA[2], voffB[2];
#pragma unroll
    for (int i = 0; i < 2; ++i) { int R, C; stage_rc(tid * 16 + i * 8192, R, C); const int Rb = Epi::PERM ? ((R & ~31) + perm32(R & 31)) : R;
        voffA[i] = (unsigned)(R * K + C) * 2u; voffB[i] = (unsigned)(Rb * K + C) * 2u; }
    const size_t kstep = (size_t)(BK * 2);
    const size_t hstep = (size_t)HALF * K * 2;
    const size_t tstep = 2 * hstep;
    const unsigned ldsw = (unsigned)wid * 1024u;
    const int aoff = lds_byte(wr * 64 + fr, fq * 8), boff = lds_byte(wc * 32 + fr, fq * 8);
#define PG8_SA(b, h) (((b) * 2 + (h)) * HTB)
#define PG8_SB(b, h) ((4 + (b) * 2 + (h)) * HTB)
#define PG8_STAGE(bufoff, gbase, voff) do { _Pragma("unroll") for (int _i = 0; _i < 2; ++_i) \
        __builtin_amdgcn_global_load_lds((const unsigned*)((const char*)(gbase) + (voff)[_i]), (PG8_LAS unsigned*)(lds + (bufoff) + ldsw + _i * 8192), 16, 0, 0); } while (0)
#define PG8_LDA(dst, b, h) do { _Pragma("unroll") for (int m = 0; m < 4; ++m) _Pragma("unroll") for (int k = 0; k < 2; ++k) dst[m][k] = *(const PG8_LAS bf16x8*)(lds + PG8_SA(b, h) + aoff + m * 2048 + k * 1024); } while (0)
#define PG8_LDB(dst, b, h) do { _Pragma("unroll") for (int n = 0; n < 2; ++n) _Pragma("unroll") for (int k = 0; k < 2; ++k) dst[n][k] = *(const PG8_LAS bf16x8*)(lds + PG8_SB(b, h) + boff + n * 2048 + k * 1024); } while (0)
#define PG8_MMA(ai, bj, At, Bt) do { __builtin_amdgcn_s_setprio(1); _Pragma("unroll") for (int m = 0; m < 4; ++m) _Pragma("unroll") for (int n = 0; n < 2; ++n) _Pragma("unroll") for (int k = 0; k < 2; ++k) \
        acc[ai][bj][m][n] = __builtin_amdgcn_mfma_f32_16x16x32_bf16(Bt[n][k], At[m][k], acc[ai][bj][m][n], 0, 0, 0); __builtin_amdgcn_s_setprio(0); } while (0)
#define PG8_WAIT_V(n) asm volatile("s_waitcnt vmcnt(" #n ")" ::: "memory")
#define PG8_WAIT_L(n) asm volatile("s_waitcnt lgkmcnt(" #n ")" ::: "memory")
#define PG8_BAR __builtin_amdgcn_s_barrier()
#define PG8_SCHED __builtin_amdgcn_sched_barrier(0)
    Unit cur, nxt; int ui = 0;
    if (!S.next(0, cur)) return;
    f32x4 acc[2][2][4][2];
#pragma unroll
    for (int a = 0; a < 2; ++a)
#pragma unroll
        for (int b = 0; b < 2; ++b)
#pragma unroll
            for (int m = 0; m < 4; ++m)
#pragma unroll
                for (int n = 0; n < 2; ++n) acc[a][b][m][n] = (f32x4){0.f, 0.f, 0.f, 0.f};
    bf16x8 At[4][2], B0[2][2], B1[2][2];
    const char* cA = (const char*)g.A + (size_t)cur.pm * tstep; const char* cB = (const char*)g.Bt + (size_t)cur.pn * tstep;
    S.a_ready(cur);
    PG8_STAGE(PG8_SB(0, 0), cB, voffB); PG8_STAGE(PG8_SB(0, 1), cB + hstep, voffB); PG8_STAGE(PG8_SA(0, 0), cA, voffA); PG8_STAGE(PG8_SA(0, 1), cA + hstep, voffA);
    if (wr == 1) PG8_BAR;
    PG8_WAIT_V(2); PG8_BAR;
    PG8_STAGE(PG8_SB(1, 0), cB + kstep, voffB); PG8_STAGE(PG8_SA(1, 0), cA + kstep, voffA); PG8_STAGE(PG8_SB(1, 1), cB + hstep + kstep, voffB);
    PG8_WAIT_V(6); PG8_BAR;
    PG8_STAMP();
    for (;;) {
        const bool has_next = S.next(ui + 1, nxt);
        const char* nA = has_next ? (const char*)g.A + (size_t)nxt.pm * tstep : cA; const char* nB = has_next ? (const char*)g.Bt + (size_t)nxt.pn * tstep : cB;
        for (int t = 0; t < nt; t += 2) {
            const bool last = (t == nt - 2);
            const char* a1 = cA + (size_t)(t + 1) * kstep;
            const char* a2 = last ? nA : cA + (size_t)(t + 2) * kstep; const char* b2 = last ? nB : cB + (size_t)(t + 2) * kstep;
            const char* a3 = a2 + kstep; const char* b3 = b2 + kstep;
            if (last && has_next) S.a_ready(nxt);
            PG8_LDB(B0, 0, 0); PG8_LDB(B1, 0, 1); PG8_SCHED; PG8_LDA(At, 0, 0); PG8_STAGE(PG8_SA(1, 1), a1 + hstep, voffA);
            PG8_WAIT_V(8); PG8_WAIT_L(0); PG8_BAR; PG8_MMA(0, 0, At, B0); PG8_MMA(0, 1, At, B1); PG8_BAR; PG8_SCHED;
            PG8_LDA(At, 0, 1); PG8_STAGE(PG8_SB(0, 0), b2, voffB); PG8_STAGE(PG8_SB(0, 1), b2 + hstep, voffB); PG8_STAGE(PG8_SA(0, 0), a2, voffA);
            PG8_WAIT_V(8); PG8_WAIT_L(0); PG8_BAR; PG8_MMA(1, 0, At, B0); PG8_MMA(1, 1, At, B1); PG8_BAR; PG8_SCHED;
            PG8_LDB(B0, 1, 0); PG8_LDB(B1, 1, 1); PG8_SCHED; PG8_LDA(At, 1, 0); PG8_STAGE(PG8_SA(0, 1), a2 + hstep, voffA);
            PG8_WAIT_V(8); PG8_WAIT_L(0); PG8_BAR; PG8_MMA(0, 0, At, B0); PG8_MMA(0, 1, At, B1); PG8_BAR; PG8_SCHED;
            PG8_LDA(At, 1, 1); PG8_STAGE(PG8_SB(1, 0), b3, voffB); PG8_STAGE(PG8_SB(1, 1), b3 + hstep, voffB); PG8_STAGE(PG8_SA(1, 0), a3, voffA);
            PG8_WAIT_V(8); PG8_WAIT_L(0); PG8_BAR; PG8_MMA(1, 0, At, B0); PG8_MMA(1, 1, At, B1); PG8_BAR; PG8_SCHED;
        }
        PG8_STAMP();
        if (wr == 0) PG8_BAR;
        if constexpr (!Epi::AFTER_DRAIN) { E(acc, cur, wr, wc, fr, fq); S.done(cur); }
        PG8_STAMP();
        if (!has_next) break;
#pragma unroll
        for (int a = 0; a < 2; ++a)
#pragma unroll
            for (int b = 0; b < 2; ++b)
#pragma unroll
                for (int m = 0; m < 4; ++m)
#pragma unroll
                    for (int n = 0; n < 2; ++n) acc[a][b][m][n] = (f32x4){0.f, 0.f, 0.f, 0.f};
        cur = nxt; cA = nA; cB = nB; ++ui;
        if (wr == 1) PG8_BAR;
    }
    PG8_WAIT_V(0);
    PG8_BAR;
    if constexpr (Epi::AFTER_DRAIN) { E.fused(acc, cur, wr, wc, fr, fq, lds, wid, lane); S.done(cur); }
    PG8_STAMP();
    if (STAMP && wid == 0) { stamps[lane] = lane < nts ? (((unsigned long long)(unsigned)ts_hi << 32) | (unsigned)ts_lo) : 0ull;
        if (lane == 62) stamps[62] = rt_entry; if (lane == 63) stamps[63] = (unsigned long long)wall_clock64(); }
#undef PG8_STAMP
#undef PG8_SA
#undef PG8_SB
#undef PG8_STAGE
#undef PG8_LDA
#undef PG8_LDB
#undef PG8_MMA
#undef PG8_WAIT_V
#undef PG8_WAIT_L
#undef PG8_BAR
#undef PG8_SCHED
}
}
#define LAS __attribute__((address_space(3)))
using pg8::bf16_t; using pg8::f32x4; using pg8::u32x4; using pg8::cvt_pk_bf16;
constexpr int S_ = 16384, D_ = 1024, FF_ = 2816, DI_ = 2048, NH_ = 32, CONVD_ = 3072, INP_ = 5376, INSRC_ = 5152;
constexpr float EPS_ = 1e-5f;
constexpr int LDS_CTL = 131072, LDS_BYTES = LDS_CTL + 64;
constexpr int NSLOT = 11, NPH = 4 * NSLOT + 1;

constexpr size_t SZ_GU = (size_t)2 * FF_ * D_ * 2, SZ_D = (size_t)D_ * FF_ * 2, SZ_MIN = (size_t)INP_ * D_ * 2, SZ_MOUT = (size_t)D_ * DI_ * 2;
constexpr size_t WS_GU1 = 0, WS_D1 = WS_GU1 + SZ_GU, WS_GU2 = WS_D1 + SZ_D, WS_D2 = WS_GU2 + SZ_GU, WS_MIN = WS_D2 + SZ_D, WS_MOUT = WS_MIN + SZ_MIN;
constexpr size_t WS_XB = WS_MOUT + SZ_MOUT;
constexpr size_t WS_SS = WS_XB + (size_t)S_ * D_ * 2;
constexpr size_t WS_DT = WS_SS + (size_t)S_ * 16 * 4;
constexpr size_t WS_R1 = WS_DT + (size_t)S_ * 32 * 4;
constexpr size_t WS_R2 = WS_R1 + (size_t)S_ * FF_ * 2;
constexpr size_t WS_R3 = WS_R2 + (size_t)S_ * CONVD_ * 2;
constexpr size_t WS_ACS = WS_R3 + (size_t)S_ * CONVD_ * 2;
constexpr size_t WS_DTT = WS_ACS + (size_t)S_ * 32 * 4;
constexpr size_t WS_RS = WS_DTT + (size_t)S_ * 32 * 4;
constexpr size_t WS_BAR = WS_RS + (size_t)S_ * 4;
constexpr size_t WS_END = WS_BAR + 16384;
constexpr size_t WS_ST = WS_R2;

struct Params {
    const float *x, *norm_w, *wg, *wu, *wd, *ssd_w_in, *ssd_conv_w, *ssd_conv_b, *ssd_dt_bias, *ssd_a_log, *ssd_d, *ssd_norm_w, *ssd_w_out, *sc_w_in, *sc_conv_w, *sc_w_out, *final_w;
    float* out; unsigned char* ws; int ph_lo, ph_hi;
};

__device__ __forceinline__ float bflo(unsigned w) { return __uint_as_float(w << 16); }
__device__ __forceinline__ float bfhi(unsigned w) { return __uint_as_float(w & 0xffff0000u); }
__device__ __forceinline__ float wave_sum(float v) {
#pragma unroll
    for (int o = 1; o < 64; o <<= 1) v += __shfl_xor(v, o);
    return v;
}
__device__ __forceinline__ float silu_f(float v) { return v * __builtin_amdgcn_rcpf(1.0f + __builtin_amdgcn_exp2f(v * -1.44269504089f)); }
__device__ __forceinline__ void unpack8(const u32x4 w, float (&f)[8]) { f[0] = bflo(w.x); f[1] = bfhi(w.x); f[2] = bflo(w.y); f[3] = bfhi(w.y); f[4] = bflo(w.z); f[5] = bfhi(w.z); f[6] = bflo(w.w); f[7] = bfhi(w.w); }

__device__ __forceinline__ int rs_index(int row) { return ((((row >> 8) * 2 + ((row >> 6) & 1)) * 16 + (row & 15)) << 3) + ((row >> 7) & 1) * 4 + ((row >> 4) & 3); }
#define XB_TMO      128
#define XB_XCNT(j)  (256  + 64 * (j))
#define XB_XSUB(j)  (1280 + 64 * (j))
#define XB_XGEN(j)  (2304 + 64 * (j))
#define XB_TOP      3328
#define XB_TOPGEN   3392
#define XCD_BAR_WORDS 3456
#define XB_SPIN_CAP (1u << 18)

__device__ __forceinline__ unsigned xb_ld(unsigned* p)              { return __hip_atomic_load(p, __ATOMIC_RELAXED, __HIP_MEMORY_SCOPE_AGENT); }
__device__ __forceinline__ unsigned xb_add(unsigned* p, unsigned v) { return __hip_atomic_fetch_add(p, v, __ATOMIC_RELAXED, __HIP_MEMORY_SCOPE_AGENT); }
__device__ __forceinline__ unsigned xb_xcc_id() { return (unsigned)__builtin_amdgcn_s_getreg((3 << 11) | 20) & 0xFu; }
#define XB_SPIN(cond, bar) do { unsigned _sp = 0; while (cond) { __builtin_amdgcn_s_sleep(1); \
    if ((++_sp & 255u) == 0u) { if (xb_ld(&(bar)[XB_TMO])) break; if (_sp > XB_SPIN_CAP) { atomicAdd(&(bar)[XB_TMO], 1u); break; } } } } while (0)

struct XcdBarrier {
    unsigned* bar; unsigned x;
    volatile LAS unsigned* st;
};

__device__ __forceinline__ XcdBarrier xcd_barrier_post(unsigned* bar, volatile LAS unsigned* st, bool t0) {
    XcdBarrier b; b.bar = bar; b.x = xb_xcc_id(); b.st = st;
    if (t0) (void)xb_add(&bar[XB_XCNT(b.x)], 1u);
    return b;
}
__device__ __forceinline__ void xcd_barrier_complete(unsigned* bar, unsigned x, unsigned& nloc, unsigned& nx) {
    const unsigned G = gridDim.x * gridDim.y * gridDim.z;
    unsigned sum, cnt, mine, sp = 0u;
    for (;;) {
        sum = 0u; cnt = 0u; mine = 0u;
#pragma unroll
        for (unsigned j = 0; j < 16; ++j) { const unsigned c = xb_ld(&bar[XB_XCNT(j)]); sum += c; cnt += (c > 0u) ? 1u : 0u; mine = (j == x) ? c : mine; }
        if (sum == G) break;
        __builtin_amdgcn_s_sleep(1);
        if ((++sp & 255u) == 0u) { if (xb_ld(&bar[XB_TMO])) break; if (sp > XB_SPIN_CAP) { atomicAdd(&bar[XB_TMO], 1u); break; } }
    }
    nloc = mine > 0u ? mine : 1u; nx = cnt > 0u ? cnt : 1u;
}

__device__ __forceinline__ void xcd_barrier(const XcdBarrier& b, bool t0) {
    asm volatile("s_waitcnt vmcnt(0)" ::: "memory");
    __syncthreads();
    if (t0) {
        unsigned* bar = b.bar;
        __builtin_amdgcn_s_waitcnt(0);
        unsigned nloc = b.st[0], nx = b.st[1];
        if (nloc == 0u) { xcd_barrier_complete(bar, b.x, nloc, nx); b.st[0] = nloc; b.st[1] = nx; }
        const unsigned old = xb_add(&bar[XB_XSUB(b.x)], 1u);
        const unsigned gen = old / nloc;
        if (old + 1u == (gen + 1u) * nloc) {
            __builtin_amdgcn_fence(__ATOMIC_RELEASE, "agent");
            asm volatile("s_waitcnt vmcnt(0)" ::: "memory");
            const unsigned og = xb_add(&bar[XB_TOP], 1u);
            const unsigned tg = og / nx;
            if (og + 1u == (tg + 1u) * nx) xb_add(&bar[XB_TOPGEN], 1u);
            else XB_SPIN(xb_ld(&bar[XB_TOPGEN]) == tg, bar);
            __builtin_amdgcn_fence(__ATOMIC_ACQUIRE, "agent");
            xb_add(&bar[XB_XGEN(b.x)], 1u);
            asm volatile("s_waitcnt vmcnt(0)" ::: "memory");
        } else {
            XB_SPIN(xb_ld(&bar[XB_XGEN(b.x)]) == gen, bar);
            __builtin_amdgcn_fence(__ATOMIC_ACQUIRE, "agent");
            asm volatile("s_waitcnt vmcnt(0)" ::: "memory");
        }
    }
    __syncthreads();
}

struct EpiAll {
    static constexpr bool PERM = true, AFTER_DRAIN = false;
    int mode;
    bf16_t* o0; int ld0, nt0; bf16_t* o1; int ld1, dt_tile;
    float* x; float* ss; float* dt; const float* dt_bias; float scale;
    const float* rsp;
    __device__ __forceinline__ void row_scales(int pm, int wr, int fr, float (&rs)[8]) const {
        const f32x4* q = (const f32x4*)(rsp + (((pm * 2 + wr) * 16 + fr) << 3)); const f32x4 a = q[0], b = q[1];
        rs[0] = a.x; rs[1] = a.y; rs[2] = a.z; rs[3] = a.w; rs[4] = b.x; rs[5] = b.y; rs[6] = b.z; rs[7] = b.w;
        rs[0] = __shfl_xor(rs[0], 16);
    }
    __device__ __forceinline__ void operator()(const f32x4 (&acc)[2][2][4][2], const pg8::Unit& u, int wr, int wc, int fr, int fq) const {
        const int row0 = u.pm * 256 + wr * 64 + fr;
        if (mode == 1) {
            const int col0 = u.pn * 256 + wc * 32 + 8 * fq;
#pragma unroll
            for (int ai = 0; ai < 2; ++ai) {
                bf16_t* xbase = o0 + (size_t)(row0 + ai * 128) * D_ + col0;
                u32x4 old[4][2];
#pragma unroll
                for (int m = 0; m < 4; ++m)
#pragma unroll
                    for (int bj = 0; bj < 2; ++bj) old[m][bj] = *(const u32x4*)(xbase + (size_t)m * 16 * D_ + bj * 128);
                u32x4 nw_[4][2]; float qq[4];
#pragma unroll
                for (int m = 0; m < 4; ++m) { float q = 0.f;
#pragma unroll
                    for (int bj = 0; bj < 2; ++bj) {
                        float xo[8]; unpack8(old[m][bj], xo);
                        f32x4 a = (f32x4){xo[0], xo[1], xo[2], xo[3]}, b = (f32x4){xo[4], xo[5], xo[6], xo[7]};
                        a = a + acc[ai][bj][m][0] * scale; b = b + acc[ai][bj][m][1] * scale;
                        q += (a.x * a.x + a.y * a.y) + (a.z * a.z + a.w * a.w) + (b.x * b.x + b.y * b.y) + (b.z * b.z + b.w * b.w);
                        u32x4 w; w.x = cvt_pk_bf16(a.x, a.y); w.y = cvt_pk_bf16(a.z, a.w); w.z = cvt_pk_bf16(b.x, b.y); w.w = cvt_pk_bf16(b.z, b.w);
                        nw_[m][bj] = w; }
                    q += __shfl_xor(q, 16); q += __shfl_xor(q, 32); qq[m] = q; }
#pragma unroll
                for (int m = 0; m < 4; ++m) {
#pragma unroll
                    for (int bj = 0; bj < 2; ++bj) *(u32x4*)(xbase + (size_t)m * 16 * D_ + bj * 128) = nw_[m][bj];
                    if (fq == 0) ss[(size_t)(row0 + ai * 128 + m * 16) * 16 + u.pn * 4 + wc] = qq[m]; }
            }
            return;
        }
        float rs[8]; row_scales(u.pm, wr, fr, rs);
        if (mode == 0) {
            const int col0 = u.pn * 128 + wc * 32 + 8 * fq;
#pragma unroll
            for (int ai = 0; ai < 2; ++ai)
#pragma unroll
                for (int m = 0; m < 4; ++m) {
                    const int row = row0 + ai * 128 + m * 16; const float r = rs[ai * 4 + m];
                    float o[8];
#pragma unroll
                    for (int n = 0; n < 2; ++n)
#pragma unroll
                        for (int j = 0; j < 4; ++j) { const float g = acc[ai][0][m][n][j] * r, v = acc[ai][1][m][n][j] * r; o[n * 4 + j] = silu_f(g) * v; }
                    u32x4 w; w.x = cvt_pk_bf16(o[0], o[1]); w.y = cvt_pk_bf16(o[2], o[3]); w.z = cvt_pk_bf16(o[4], o[5]); w.w = cvt_pk_bf16(o[6], o[7]);
                    *(u32x4*)(o0 + (size_t)row * ld0 + col0) = w; }
        } else if (u.pn != dt_tile) {
            bf16_t* base; int ld, colt;
            if (u.pn < nt0) { base = o0; ld = ld0; colt = u.pn * 256; } else { base = o1; ld = ld1; colt = (u.pn - nt0) * 256; }
            const int col0 = colt + wc * 32 + 8 * fq;
#pragma unroll
            for (int ai = 0; ai < 2; ++ai)
#pragma unroll
                for (int m = 0; m < 4; ++m) {
                    const int row = row0 + ai * 128 + m * 16; const float r = rs[ai * 4 + m];
#pragma unroll
                    for (int bj = 0; bj < 2; ++bj) {
                        const f32x4 a = acc[ai][bj][m][0] * r, b = acc[ai][bj][m][1] * r;
                        u32x4 w; w.x = cvt_pk_bf16(a.x, a.y); w.y = cvt_pk_bf16(a.z, a.w); w.z = cvt_pk_bf16(b.x, b.y); w.w = cvt_pk_bf16(b.z, b.w);
                        *(u32x4*)(base + (size_t)row * ld + col0 + bj * 128) = w; } }
        } else if (wc == 0) {
            const f32x4 b0 = *(const f32x4*)(dt_bias + 8 * fq), b1 = *(const f32x4*)(dt_bias + 8 * fq + 4);
#pragma unroll
            for (int ai = 0; ai < 2; ++ai)
#pragma unroll
                for (int m = 0; m < 4; ++m) {
                    const int row = row0 + ai * 128 + m * 16; const float r = rs[ai * 4 + m];
                    f32x4 a = acc[ai][0][m][0] * r + b0, b = acc[ai][0][m][1] * r + b1;
#pragma unroll
                    for (int j = 0; j < 4; ++j) { a[j] = fmaxf(a[j], 0.f) + log1pf(__expf(-fabsf(a[j]))); b[j] = fmaxf(b[j], 0.f) + log1pf(__expf(-fabsf(b[j]))); }
                    float* o = dt + (size_t)row * 32 + 8 * fq; *(f32x4*)o = a; *(f32x4*)(o + 4) = b; }
        }
    }
};

template <class Epi> __device__ __forceinline__ void run_gemm(LAS unsigned char* lds, const bf16_t* A, const bf16_t* Bt, int N, int K, const Epi& E, int wv) {
    pg8::Gemm g; g.A = A; g.Bt = Bt; g.M = S_; g.N = N; g.K = K;
    pg8::StaticOrder S; S.init(S_, N, (int)gridDim.x, (int)blockIdx.x);
    pg8::gemm_phase<Epi, pg8::StaticOrder, false>(lds, g, S, E, nullptr, wv);
}

__device__ __forceinline__ void tr_item(const float* W, int ldw, int k0, int scol0, const float* scale, bf16_t* WT, int K, int drow0, LAS float* scr, int lane) {
    float v[32];
    const float* wp = W + (size_t)(k0 + (lane >> 5)) * ldw + scol0 + (lane & 31);
#pragma unroll
    for (int i = 0; i < 32; ++i) v[i] = wp[(size_t)(2 * i) * ldw];
    if (scale) {
#pragma unroll
        for (int i = 0; i < 32; ++i) v[i] *= scale[k0 + 2 * i + (lane >> 5)]; }
#pragma unroll
    for (int i = 0; i < 32; ++i) scr[(2 * i + (lane >> 5)) * 33 + (lane & 31)] = v[i];
    asm volatile("s_waitcnt lgkmcnt(0)" ::: "memory");
    const int c = lane & 7;
#pragma unroll
    for (int j = 0; j < 4; ++j) { const int n = (lane >> 3) + 8 * j; const LAS float* s = scr + (8 * c) * 33 + n;
        u32x4 o; o.x = cvt_pk_bf16(s[0 * 33], s[1 * 33]); o.y = cvt_pk_bf16(s[2 * 33], s[3 * 33]); o.z = cvt_pk_bf16(s[4 * 33], s[5 * 33]); o.w = cvt_pk_bf16(s[6 * 33], s[7 * 33]);
        *(u32x4*)(WT + (size_t)(drow0 + n) * K + k0 + 8 * c) = o; }
    asm volatile("s_waitcnt lgkmcnt(0)" ::: "memory");
}

__device__ __forceinline__ void rs_phase(const Params& p, int wv) {
    const float* ss = (const float*)(p.ws + WS_SS); float* rsp = (float*)(p.ws + WS_RS);
    for (int t = bid_opaque() * 512 + fresh_tid(wv); t < S_ * 8; t += gridDim.x * 512) {
        const int row = t >> 3, part = t & 7; const float* q = ss + (size_t)row * 16 + 2 * part;
        float v = q[0] + q[1]; v += __shfl_xor(v, 1); v += __shfl_xor(v, 2); v += __shfl_xor(v, 4);
        if (part == 0) rsp[rs_index(row)] = rsqrtf(v * (1.0f / D_) + EPS_);
    }
}
__device__ __forceinline__ void prep_phase(const Params& p, int layer, LAS unsigned char* lds, int wv) {
    const int lane = fresh_tid(wv) & 63, wave = fresh_tid(wv) >> 6;
    LAS float* scr = (LAS float*)(lds + wave * 8448);
    const int gw = bid_opaque() * 8 + wave, NGW = gridDim.x * 8;
    const bool ssd = !(layer & 1); const int j = layer >> 1;
    const float* nw = p.norm_w + (size_t)layer * 3 * D_;
    constexpr int I_GU = (D_ / 64) * (FF_ / 32), I_D = (FF_ / 64) * (D_ / 32);
    const int nbin = ssd ? INSRC_ / 32 : CONVD_ / 32, I_MIN = (D_ / 64) * nbin, kout = ssd ? DI_ : D_, I_MOUT = (kout / 64) * (D_ / 32);
    const int total = 4 * I_GU + 2 * I_D + I_MIN + I_MOUT;
    for (int it = gw; it < total; it += NGW) {
        int r = it;
        if (r < 4 * I_GU) { const int which = r / I_GU; r -= which * I_GU; const int f = which >> 1, s = which & 1;
            const float* W = (s ? p.wu : p.wg) + (size_t)(layer * 2 + f) * D_ * FF_;
            const int kb = r / (FF_ / 32), nb = r - kb * (FF_ / 32), h0 = nb * 32, drow0 = 256 * (h0 >> 7) + 128 * s + (h0 & 127);
            tr_item(W, FF_, kb * 64, h0, nw + (f ? 2 * D_ : 0), (bf16_t*)(p.ws + (f ? WS_GU2 : WS_GU1)), D_, drow0, scr, lane); continue; }
        r -= 4 * I_GU;
        if (r < 2 * I_D) { const int f = r / I_D; r -= f * I_D;
            const float* W = p.wd + (size_t)(layer * 2 + f) * FF_ * D_;
            const int kb = r / (D_ / 32), nb = r - kb * (D_ / 32);
            tr_item(W, D_, kb * 64, nb * 32, nullptr, (bf16_t*)(p.ws + (f ? WS_D2 : WS_D1)), FF_, nb * 32, scr, lane); continue; }
        r -= 2 * I_D;
        if (r < I_MIN) { const int kb = r / nbin, nb = r - kb * nbin;
            const float* W = ssd ? p.ssd_w_in + (size_t)j * D_ * INSRC_ : p.sc_w_in + (size_t)j * D_ * CONVD_;
            tr_item(W, ssd ? INSRC_ : CONVD_, kb * 64, nb * 32, nw + D_, (bf16_t*)(p.ws + WS_MIN), D_, nb * 32, scr, lane); continue; }
        r -= I_MIN;
        { const int kb = r / (D_ / 32), nb = r - kb * (D_ / 32);
            const float* W = ssd ? p.ssd_w_out + (size_t)j * DI_ * D_ : p.sc_w_out + (size_t)j * D_ * D_;
            tr_item(W, D_, kb * 64, nb * 32, nullptr, (bf16_t*)(p.ws + WS_MOUT), kout, nb * 32, scr, lane); }
    }
    if (layer == 0) {
        bf16_t* xb = (bf16_t*)(p.ws + WS_XB); float* ss = (float*)(p.ws + WS_SS);
        for (int row = gw; row < S_; row += NGW) {
            const f32x4* xr = (const f32x4*)(p.x + (size_t)row * D_) + lane;
            unsigned long long* o8 = (unsigned long long*)(xb + (size_t)row * D_) + lane; float s = 0.f;
#pragma unroll
            for (int q = 0; q < 4; ++q) { const f32x4 v = xr[64 * q]; s += (v.x * v.x + v.y * v.y) + (v.z * v.z + v.w * v.w);
                o8[64 * q] = (unsigned long long)cvt_pk_bf16(v.x, v.y) | ((unsigned long long)cvt_pk_bf16(v.z, v.w) << 32); }
            s = wave_sum(s);
            if (lane < 16) ss[(size_t)row * 16 + lane] = lane == 0 ? s : 0.f;
            if (lane == 0) ((float*)(p.ws + WS_RS))[rs_index(row)] = rsqrtf(s * (1.0f / D_) + EPS_);
        }
    } else rs_phase(p, wv);
}

__device__ __forceinline__ u32x4 pack8(const float (&f)[8]) { u32x4 w; w.x = cvt_pk_bf16(f[0], f[1]); w.y = cvt_pk_bf16(f[2], f[3]); w.z = cvt_pk_bf16(f[4], f[5]); w.w = cvt_pk_bf16(f[6], f[7]); return w; }

__device__ __forceinline__ void sc_conv_phase(const Params& p, int j, int wv) {
    const bf16_t* bcu = (const bf16_t*)(p.ws + WS_R2); bf16_t* vo = (bf16_t*)(p.ws + WS_R1); const float* cw = p.sc_conv_w + (size_t)j * 3 * D_;
    const int nthr = gridDim.x * 512;
    for (int idx = bid_opaque() * 512 + fresh_tid(wv); idx < (S_ / 16) * 128; idx += nthr) {
        const int tb = idx >> 7, c = (idx & 127) * 8, t0 = tb * 16;
        float w[3][8];
#pragma unroll
        for (int k = 0; k < 3; ++k) { const f32x4 w0 = *(const f32x4*)(cw + k * D_ + c), w1 = *(const f32x4*)(cw + k * D_ + c + 4);
#pragma unroll
            for (int e = 0; e < 4; ++e) { w[k][e] = w0[e]; w[k][4 + e] = w1[e]; } }
        float h0[8], h1[8];
#pragma unroll
        for (int e = 0; e < 8; ++e) { h0[e] = 0.f; h1[e] = 0.f; }
        if (t0 > 0) { float a[8], b[8];
            unpack8(*(const u32x4*)(bcu + (size_t)(t0 - 2) * CONVD_ + D_ + c), a); unpack8(*(const u32x4*)(bcu + (size_t)(t0 - 2) * CONVD_ + 2 * D_ + c), b);
#pragma unroll
            for (int e = 0; e < 8; ++e) h0[e] = a[e] * b[e];
            unpack8(*(const u32x4*)(bcu + (size_t)(t0 - 1) * CONVD_ + D_ + c), a); unpack8(*(const u32x4*)(bcu + (size_t)(t0 - 1) * CONVD_ + 2 * D_ + c), b);
#pragma unroll
            for (int e = 0; e < 8; ++e) h1[e] = a[e] * b[e]; }
        const bf16_t* row = bcu + (size_t)t0 * CONVD_ + c; bf16_t* orow = vo + (size_t)t0 * D_ + c;
#pragma unroll 8
        for (int r = 0; r < 16; ++r) {
            float bg[8], cgv[8], uv[8], o[8];
            unpack8(*(const u32x4*)(row + (size_t)r * CONVD_), bg); unpack8(*(const u32x4*)(row + (size_t)r * CONVD_ + D_), cgv); unpack8(*(const u32x4*)(row + (size_t)r * CONVD_ + 2 * D_), uv);
#pragma unroll
            for (int e = 0; e < 8; ++e) { const float cu = cgv[e] * uv[e]; o[e] = bg[e] * (w[0][e] * h0[e] + w[1][e] * h1[e] + w[2][e] * cu); h0[e] = h1[e]; h1[e] = cu; }
            *(u32x4*)(orow + (size_t)r * D_) = pack8(o);
        }
    }
}
__device__ __forceinline__ void ssd_conv_phase(const Params& p, int j, int wv) {
    const bf16_t* raw = (const bf16_t*)(p.ws + WS_R2); bf16_t* xo = (bf16_t*)(p.ws + WS_R3);
    const float* cw = p.ssd_conv_w + (size_t)j * 4 * CONVD_; const float* cb = p.ssd_conv_b + (size_t)j * CONVD_;
    const int nthr = gridDim.x * 512;
    for (int idx = bid_opaque() * 512 + fresh_tid(wv); idx < (S_ / 64) * 384; idx += nthr) {
        const int tb = idx / 384, c = (idx - tb * 384) * 8, t0 = tb * 64;
        float w[4][8], bias[8];
#pragma unroll
        for (int k = 0; k < 4; ++k) { const f32x4 w0 = *(const f32x4*)(cw + k * CONVD_ + c), w1 = *(const f32x4*)(cw + k * CONVD_ + c + 4);
#pragma unroll
            for (int e = 0; e < 4; ++e) { w[k][e] = w0[e]; w[k][4 + e] = w1[e]; } }
        { const f32x4 b0 = *(const f32x4*)(cb + c), b1 = *(const f32x4*)(cb + c + 4);
#pragma unroll
          for (int e = 0; e < 4; ++e) { bias[e] = b0[e]; bias[4 + e] = b1[e]; } }
        float h0[8], h1[8], h2[8];
#pragma unroll
        for (int e = 0; e < 8; ++e) { h0[e] = 0.f; h1[e] = 0.f; h2[e] = 0.f; }
        if (t0 > 0) { unpack8(*(const u32x4*)(raw + (size_t)(t0 - 3) * CONVD_ + c), h0); unpack8(*(const u32x4*)(raw + (size_t)(t0 - 2) * CONVD_ + c), h1); unpack8(*(const u32x4*)(raw + (size_t)(t0 - 1) * CONVD_ + c), h2); }
        const bf16_t* row = raw + (size_t)t0 * CONVD_ + c; bf16_t* orow = xo + (size_t)t0 * CONVD_ + c;
#pragma unroll 8
        for (int r = 0; r < 64; ++r) {
            float v[8], o[8]; unpack8(*(const u32x4*)(row + (size_t)r * CONVD_), v);
#pragma unroll
            for (int e = 0; e < 8; ++e) { o[e] = silu_f(bias[e] + w[0][e] * h0[e] + w[1][e] * h1[e] + w[2][e] * h2[e] + w[3][e] * v[e]); h0[e] = h1[e]; h1[e] = h2[e]; h2[e] = v[e]; }
            *(u32x4*)(orow + (size_t)r * CONVD_) = pack8(o);
        }
    }
}
__device__ __forceinline__ void ssd_dt_phase(const Params& p, int j, int wv) {
    const int tid = fresh_tid(wv), lane = tid & 63, wave = tid >> 6, fr = lane & 15, fq = lane >> 4;
    const bf16_t* xb = (const bf16_t*)(p.ws + WS_XB); const bf16_t* wdt = (const bf16_t*)(p.ws + WS_MIN) + (size_t)5120 * D_; const float* ss = (const float*)(p.ws + WS_SS); float* dt = (float*)(p.ws + WS_DT);
    const float* bias = p.ssd_dt_bias + j * NH_;
    for (int tile = bid_opaque() * 8 + wave; tile < S_ / 16; tile += gridDim.x * 8) {
        const int r0 = tile * 16;
        const bf16_t* ap = xb + (size_t)(r0 + fr) * D_ + 8 * fq; const bf16_t* bp = wdt + (size_t)fr * D_ + 8 * fq;
        f32x4 acc0 = (f32x4){0.f, 0.f, 0.f, 0.f}, acc1 = acc0;
#pragma unroll 8
        for (int ks = 0; ks < 32; ++ks) {
            const pg8::bf16x8 a = *(const pg8::bf16x8*)(ap + ks * 32), b0 = *(const pg8::bf16x8*)(bp + ks * 32), b1 = *(const pg8::bf16x8*)(bp + 16 * D_ + ks * 32);
            acc0 = __builtin_amdgcn_mfma_f32_16x16x32_bf16(b0, a, acc0, 0, 0, 0); acc1 = __builtin_amdgcn_mfma_f32_16x16x32_bf16(b1, a, acc1, 0, 0, 0);
        }
        const float rs = ((const float*)(p.ws + WS_RS))[rs_index(r0 + fr)];
        const f32x4 bb0 = *(const f32x4*)(bias + 4 * fq), bb1 = *(const f32x4*)(bias + 16 + 4 * fq);
        f32x4 a = acc0 * rs + bb0, b = acc1 * rs + bb1;
#pragma unroll
        for (int e = 0; e < 4; ++e) { a[e] = fmaxf(a[e], 0.f) + log1pf(__expf(-fabsf(a[e]))); b[e] = fmaxf(b[e], 0.f) + log1pf(__expf(-fabsf(b[e]))); }
        float* o = dt + (size_t)(r0 + fr) * 32 + 4 * fq; *(f32x4*)o = a; *(f32x4*)(o + 16) = b;
    }
}
__device__ __forceinline__ void ssd_acs_phase(const Params& p, int j, int wv) {
    const float* dt = (const float*)(p.ws + WS_DT); float* acsT = (float*)(p.ws + WS_ACS); float* dtT = (float*)(p.ws + WS_DTT);
    const int tid = fresh_tid(wv), lane = tid & 63, wave = tid >> 6;
    for (int it = bid_opaque() * 8 + wave; it < 128 * NH_; it += gridDim.x * 8) {
        const int c = it >> 5, h = it & 31; const float a = -__expf(p.ssd_a_log[j * NH_ + h]);
        const size_t t0 = (size_t)c * 128 + 2 * lane; const float d0 = dt[t0 * 32 + h], d1 = dt[(t0 + 1) * 32 + h];
        const float v0 = d0 * a, v1 = d1 * a; float s = v0 + v1;
#pragma unroll
        for (int o = 1; o < 64; o <<= 1) { const float t = __shfl_up(s, o); if (lane >= o) s += t; }
        const float ex = s - (v0 + v1); const size_t o = (size_t)it * 128 + 2 * lane;
        acsT[o] = ex + v0; acsT[o + 1] = ex + v0 + v1; dtT[o] = d0; dtT[o + 1] = d1;
    }
}
typedef short s16x4 __attribute__((ext_vector_type(4)));
__device__ __forceinline__ pg8::bf16x8 tr8(LAS unsigned char* lane_base, int off, int stride) {
    const s16x4 lo = __builtin_amdgcn_ds_read_tr16_b64_v4i16((LAS s16x4*)(lane_base + off));
    const s16x4 hi = __builtin_amdgcn_ds_read_tr16_b64_v4i16((LAS s16x4*)(lane_base + off + 4 * stride));
    pg8::bf16x8 r; r[0] = lo[0]; r[1] = lo[1]; r[2] = lo[2]; r[3] = lo[3]; r[4] = hi[0]; r[5] = hi[1]; r[6] = hi[2]; r[7] = hi[3]; return r;
}
__device__ __forceinline__ unsigned long long pack4(const f32x4 v) { return (unsigned long long)cvt_pk_bf16(v.x, v.y) | ((unsigned long long)cvt_pk_bf16(v.z, v.w) << 32); }
constexpr int XS_STRIDE = 1056, BS_STRIDE = 160, CS_STRIDE = 272;
__device__ __forceinline__ void ssd_states_phase(const Params& p, LAS unsigned char* lds, int wv) {
    const int tid = fresh_tid(wv), lane = tid & 63, wave = tid >> 6, fr = lane & 15, fq = lane >> 4;
    const bf16_t* xc = (const bf16_t*)(p.ws + WS_R3); const float* acsT = (const float*)(p.ws + WS_ACS); const float* dtT = (const float*)(p.ws + WS_DTT); bf16_t* st = (bf16_t*)(p.ws + WS_ST);
    LAS unsigned char* Xs = lds; LAS unsigned char* Bs = lds + 64 * XS_STRIDE; LAS float* wt = (LAS float*)(lds + 64 * XS_STRIDE + 64 * BS_STRIDE);
    LAS unsigned char* trB = Bs + (8 * fq + (fr >> 2)) * BS_STRIDE + 8 * (lane & 3);
    LAS unsigned char* trX = Xs + (8 * fq + (fr >> 2)) * XS_STRIDE + 8 * (lane & 3) + wave * 128;
#pragma unroll 1
    for (int it = bid_opaque(); it < 1024; it += gridDim.x) {
        const int item = 2 * (it % 512) + it / 512 * 0 + ((it >= 512) ? 1 : 0);
        const int c = item >> 3, g = (item >> 1) & 3, nh = item & 1;
        __syncthreads();
        for (int i = tid; i < 1024; i += 512) { const int e = i >> 7, l = i & 127; const size_t o = (size_t)(c * 32 + g * 8 + e) * 128; wt[i] = dtT[o + l] * __expf(acsT[o + 127] - acsT[o + l]); }
        f32x4 acc[4][4];
#pragma unroll
        for (int a = 0; a < 4; ++a)
#pragma unroll
            for (int b = 0; b < 4; ++b) acc[a][b] = (f32x4){0.f, 0.f, 0.f, 0.f};
#pragma unroll 1
        for (int half = 0; half < 2; ++half) {
            __syncthreads();
            {
                const int ch = tid & 63, r0 = tid >> 6;
                const bf16_t* xsrc = xc + (size_t)(c * 128 + half * 64 + r0) * CONVD_ + g * 512 + ch * 8;
                u32x4 v[8];
#pragma unroll
                for (int u = 0; u < 8; ++u) v[u] = *(const u32x4*)(xsrc + (size_t)u * 8 * CONVD_);
                const int rb = tid >> 3, cb8 = tid & 7;
                const u32x4 bv = *(const u32x4*)(xc + (size_t)(c * 128 + half * 64 + rb) * CONVD_ + DI_ + g * 128 + nh * 64 + cb8 * 8);
#pragma unroll
                for (int u = 0; u < 8; ++u) { float f[8]; unpack8(v[u], f); const float w = wt[(ch >> 3) * 128 + half * 64 + r0 + 8 * u];
#pragma unroll
                    for (int e = 0; e < 8; ++e) f[e] *= w;
                    *(LAS u32x4*)(Xs + (r0 + 8 * u) * XS_STRIDE + ch * 16) = pack8(f); }
                *(LAS u32x4*)(Bs + rb * BS_STRIDE + cb8 * 16) = bv;
            }
            __syncthreads();
#pragma unroll
            for (int ks = 0; ks < 2; ++ks) {
                pg8::bf16x8 ap[4];
#pragma unroll
                for (int pt = 0; pt < 4; ++pt) ap[pt] = tr8(trX, ks * 32 * XS_STRIDE + pt * 32, XS_STRIDE);
#pragma unroll
                for (int nt = 0; nt < 4; ++nt) { const pg8::bf16x8 bn = tr8(trB, ks * 32 * BS_STRIDE + nt * 32, BS_STRIDE);
#pragma unroll
                    for (int pt = 0; pt < 4; ++pt) acc[pt][nt] = __builtin_amdgcn_mfma_f32_16x16x32_bf16(bn, ap[pt], acc[pt][nt], 0, 0, 0); }
            }
        }
        bf16_t* so = st + (size_t)(c * 32 + g * 8 + wave) * 64 * 128 + fr * 128 + nh * 64 + 4 * fq;
#pragma unroll
        for (int pt = 0; pt < 4; ++pt)
#pragma unroll
            for (int nt = 0; nt < 4; ++nt) *(unsigned long long*)(so + pt * 16 * 128 + nt * 16) = pack4(acc[pt][nt]);
    }
}
__device__ __forceinline__ void ssd_cscan_phase(const Params& p, int wv) {
    const float* acsT = (const float*)(p.ws + WS_ACS); bf16_t* st = (bf16_t*)(p.ws + WS_ST);
    for (int e2 = bid_opaque() * 512 + fresh_tid(wv); e2 < NH_ * 4096; e2 += gridDim.x * 512) {
        const int h = e2 >> 12, rem = e2 & 4095; float r0 = 0.f, r1 = 0.f;
#pragma unroll 8
        for (int c = 0; c < 128; ++c) {
            unsigned* ptr = (unsigned*)(st + (size_t)(c * 32 + h) * 8192 + 2 * rem); const unsigned v = *ptr; const float d = __expf(acsT[(size_t)(c * 32 + h) * 128 + 127]);
            *ptr = cvt_pk_bf16(r0, r1); r0 = d * r0 + bflo(v); r1 = d * r1 + bfhi(v);
        }
    }
}
__device__ __forceinline__ void ssd_yout_phase(const Params& p, int j, LAS unsigned char* lds, int wv) {
    const int tid = fresh_tid(wv), lane = tid & 63, wave = tid >> 6, fr = lane & 15, fq = lane >> 4;
    const bf16_t* xc = (const bf16_t*)(p.ws + WS_R3); const float* acsT = (const float*)(p.ws + WS_ACS); const float* dtT = (const float*)(p.ws + WS_DTT);
    const bf16_t* st = (const bf16_t*)(p.ws + WS_ST); bf16_t* zg = (bf16_t*)(p.ws + WS_R1); const float* nw = p.ssd_norm_w + (size_t)j * DI_;
    LAS unsigned char* Cs = lds; LAS unsigned char* CBs = lds + 64 * CS_STRIDE; LAS unsigned char* Xs = lds + 128 * CS_STRIDE; LAS unsigned char* Bs = Xs;
    LAS float* acs_t = (LAS float*)(lds + 128 * CS_STRIDE + 64 * XS_STRIDE); LAS float* dt_t = acs_t + 1024; LAS float* red = dt_t + 1024;
    LAS unsigned char* cfb = Cs + fr * CS_STRIDE + 16 * fq;
    LAS unsigned char* bfb = Bs + fr * CS_STRIDE + 16 * fq;
    LAS unsigned char* cbr = CBs + fr * CS_STRIDE + 16 * fq;
    LAS unsigned char* trX = Xs + (8 * fq + (fr >> 2)) * XS_STRIDE + 8 * (lane & 3) + wave * 128;
    LAS float* redw = red + fr * 8;
#pragma unroll 1
    for (int it = bid_opaque(); it < 1024; it += gridDim.x) {
        const int item = 2 * (it % 512) + ((it >= 512) ? 1 : 0);
        const int c = item >> 3, g = (item >> 1) & 3, lh = item & 1, h = g * 8 + wave; const size_t trow = (size_t)c * 128; const int lbase = 64 * lh;
        LAS float* acl = acs_t + wave * 128 + lbase + fr;
        LAS float* acq = acs_t + wave * 128 + 8 * fq;
        __syncthreads();
        {
            const int r = tid >> 4, ch = tid & 15;
            const bf16_t* bsrc = xc + (trow + r) * CONVD_ + DI_ + g * 128 + ch * 8; const bf16_t* csrc = xc + (trow + lbase + r) * CONVD_ + DI_ + 512 + g * 128 + ch * 8;
            const size_t o = (size_t)(c * 32 + g * 8) * 128 + tid;
            u32x4 bv[4], cv[2];
#pragma unroll
            for (int u = 0; u < 4; ++u) bv[u] = (u < 2 || lh) ? *(const u32x4*)(bsrc + (size_t)u * 32 * CONVD_) : (u32x4){0u, 0u, 0u, 0u};
#pragma unroll
            for (int u = 0; u < 2; ++u) cv[u] = *(const u32x4*)(csrc + (size_t)u * 32 * CONVD_);
            const float a0 = acsT[o], a1 = acsT[o + 512], d0 = dtT[o], d1 = dtT[o + 512];
#pragma unroll
            for (int u = 0; u < 4; ++u) *(LAS u32x4*)(Bs + (r + 32 * u) * CS_STRIDE + ch * 16) = bv[u];
#pragma unroll
            for (int u = 0; u < 2; ++u) *(LAS u32x4*)(Cs + (r + 32 * u) * CS_STRIDE + ch * 16) = cv[u];
            acs_t[tid] = a0; acs_t[tid + 512] = a1; dt_t[tid] = d0; dt_t[tid + 512] = d1;
        }
        __syncthreads();
        {
            const int lt = wave & 3, sg = wave >> 2, mt = 4 * lh + lt;
            pg8::bf16x8 cf[4];
#pragma unroll
            for (int ks = 0; ks < 4; ++ks) cf[ks] = *(const LAS pg8::bf16x8*)(cfb + lt * 16 * CS_STRIDE + ks * 64);
#pragma unroll
            for (int si = 0; si < 4; ++si) {
                const int s8 = 4 * sg + si;
                if (s8 <= (mt | 1)) {
                    f32x4 a = (f32x4){0.f, 0.f, 0.f, 0.f};
#pragma unroll
                    for (int ks = 0; ks < 4; ++ks) { const pg8::bf16x8 bf = *(const LAS pg8::bf16x8*)(bfb + s8 * 16 * CS_STRIDE + ks * 64); a = __builtin_amdgcn_mfma_f32_16x16x32_bf16(bf, cf[ks], a, 0, 0, 0); }
                    *(LAS unsigned long long*)(CBs + (lt * 16 + fr) * CS_STRIDE + (s8 * 16 + 4 * fq) * 2) = pack4(a);
                }
            }
        }
        f32x4 acc[4][4];
#pragma unroll
        for (int a = 0; a < 4; ++a)
#pragma unroll
            for (int b = 0; b < 4; ++b) acc[a][b] = (f32x4){0.f, 0.f, 0.f, 0.f};
        {
            const bf16_t* pv = st + (size_t)(c * 32 + h) * 8192 + fr * 128 + 8 * fq;
#pragma unroll
            for (int ks = 0; ks < 4; ++ks) {
                pg8::bf16x8 pf[4];
#pragma unroll
                for (int pt = 0; pt < 4; ++pt) pf[pt] = *(const pg8::bf16x8*)(pv + pt * 16 * 128 + ks * 32);
#pragma unroll
                for (int lt = 0; lt < 4; ++lt) { const pg8::bf16x8 cf = *(const LAS pg8::bf16x8*)(cfb + lt * 16 * CS_STRIDE + ks * 64);
#pragma unroll
                    for (int pt = 0; pt < 4; ++pt) acc[lt][pt] = __builtin_amdgcn_mfma_f32_16x16x32_bf16(pf[pt], cf, acc[lt][pt], 0, 0, 0); }
            }
#pragma unroll
            for (int lt = 0; lt < 4; ++lt) { const float sc = __expf(acl[lt * 16]);
#pragma unroll
                for (int pt = 0; pt < 4; ++pt) acc[lt][pt] = acc[lt][pt] * sc; }
        }
#pragma unroll 1
        for (int half = 0; half <= lh; ++half) {
            __syncthreads();
            {
                const int ch = tid & 63, r0 = tid >> 6;
                const bf16_t* xsrc = xc + (trow + half * 64 + r0) * CONVD_ + g * 512 + ch * 8;
                u32x4 v[8];
#pragma unroll
                for (int u = 0; u < 8; ++u) v[u] = *(const u32x4*)(xsrc + (size_t)u * 8 * CONVD_);
#pragma unroll
                for (int u = 0; u < 8; ++u) { float f[8]; unpack8(v[u], f); const float w = dt_t[(ch >> 3) * 128 + half * 64 + r0 + 8 * u];
#pragma unroll
                    for (int e = 0; e < 8; ++e) f[e] *= w;
                    *(LAS u32x4*)(Xs + (r0 + 8 * u) * XS_STRIDE + ch * 16) = pack8(f); }
            }
            __syncthreads();
#pragma unroll
            for (int kk = 0; kk < 2; ++kk) {
                const int kt = 2 * half + kk;
                pg8::bf16x8 xf[4];
#pragma unroll
                for (int pt = 0; pt < 4; ++pt) xf[pt] = tr8(trX, kk * 32 * XS_STRIDE + pt * 32, XS_STRIDE);
                const f32x4 as0 = *(const LAS f32x4*)(acq + kt * 32), as1 = *(const LAS f32x4*)(acq + kt * 32 + 4);
                const float asv[8] = {as0.x, as0.y, as0.z, as0.w, as1.x, as1.y, as1.z, as1.w};
#pragma unroll
                for (int lt = 0; lt < 4; ++lt) {
                    const int mt = 4 * lh + lt;
                    if (mt >= 2 * kt) {
                        const int dl = mt * 16 + fr - kt * 32 - 8 * fq;
                        const float al = acl[lt * 16];
                        float cb[8]; unpack8(*(const LAS u32x4*)(cbr + lt * 16 * CS_STRIDE + kt * 64), cb);
#pragma unroll
                        for (int e = 0; e < 8; ++e) cb[e] = (e <= dl) ? cb[e] * __expf(fminf(al - asv[e], 0.f)) : 0.f;
                        const u32x4 pw = pack8(cb); const pg8::bf16x8 pfr = __builtin_bit_cast(pg8::bf16x8, pw);
#pragma unroll
                        for (int pt = 0; pt < 4; ++pt) acc[lt][pt] = __builtin_amdgcn_mfma_f32_16x16x32_bf16(xf[pt], pfr, acc[lt][pt], 0, 0, 0);
                    }
                }
            }
        }
        const float Dh = p.ssd_d[j * NH_ + h];
        const bf16_t* xrow = xc + (trow + lbase + fr) * CONVD_ + h * 64 + 4 * fq; bf16_t* zrow = zg + (trow + lbase + fr) * DI_ + h * 64 + 4 * fq;
#pragma unroll
        for (int lt = 0; lt < 4; ++lt) {
            float q = 0.f;
#pragma unroll
            for (int pt = 0; pt < 4; ++pt) {
                const unsigned long long xv = *(const unsigned long long*)(xrow + (size_t)lt * 16 * CONVD_ + pt * 16), zv = *(const unsigned long long*)(zrow + (size_t)lt * 16 * DI_ + pt * 16);
                const float x4[4] = {bflo((unsigned)xv), bfhi((unsigned)xv), bflo((unsigned)(xv >> 32)), bfhi((unsigned)(xv >> 32))};
                const float z4[4] = {bflo((unsigned)zv), bfhi((unsigned)zv), bflo((unsigned)(zv >> 32)), bfhi((unsigned)(zv >> 32))};
#pragma unroll
                for (int e = 0; e < 4; ++e) { const float y = (acc[lt][pt][e] + Dh * x4[e]) * silu_f(z4[e]); acc[lt][pt][e] = y; q += y * y; }
            }
            q += __shfl_xor(q, 16); q += __shfl_xor(q, 32);
            if (fq == 0) redw[lt * 128 + wave] = q;
        }
        __syncthreads();
        const float* nwl = nw + h * 64 + 4 * fq;
#pragma unroll
        for (int lt = 0; lt < 4; ++lt) {
            const f32x4 r0 = *(const LAS f32x4*)(redw + lt * 128), r1 = *(const LAS f32x4*)(redw + lt * 128 + 4);
            const float rs = rsqrtf((((r0.x + r0.y) + (r0.z + r0.w)) + ((r1.x + r1.y) + (r1.z + r1.w))) * (1.0f / 512.f) + EPS_);
#pragma unroll
            for (int pt = 0; pt < 4; ++pt) { const f32x4 w = *(const f32x4*)(nwl + pt * 16);
                *(unsigned long long*)(zrow + (size_t)lt * 16 * DI_ + pt * 16) = pack4(acc[lt][pt] * rs * w); }
        }
    }
}
__device__ __forceinline__ void final_phase(const Params& p, int wv) {
    const int tid = fresh_tid(wv), lane = tid & 63, wave = tid >> 6; const bf16_t* xb = (const bf16_t*)(p.ws + WS_XB);
    for (int row = bid_opaque() * 8 + wave; row < S_; row += gridDim.x * 8) {
        const u32x4* xr = (const u32x4*)(xb + (size_t)row * D_) + lane; f32x4* orow = (f32x4*)(p.out + (size_t)row * D_) + 2 * lane; const f32x4* wr = (const f32x4*)p.final_w + 2 * lane;
        float v[2][8]; float s = 0.f;
#pragma unroll
        for (int q = 0; q < 2; ++q) { unpack8(xr[64 * q], v[q]);
#pragma unroll
            for (int e = 0; e < 8; ++e) s += v[q][e] * v[q][e]; }
        const float rs = rsqrtf(wave_sum(s) * (1.0f / D_) + EPS_);
#pragma unroll
        for (int q = 0; q < 2; ++q) { const f32x4 w0 = wr[128 * q], w1 = wr[128 * q + 1];
            orow[128 * q] = (f32x4){v[q][0], v[q][1], v[q][2], v[q][3]} * rs * w0; orow[128 * q + 1] = (f32x4){v[q][4], v[q][5], v[q][6], v[q][7]} * rs * w1; }
    }
}

__host__ __device__ inline bool phase_active(int ph) { if (ph >= NPH - 1) return ph == NPH - 1; const int layer = ph / NSLOT, k = ph % NSLOT; return !((layer & 1) && (k >= 5 && k <= 7)); }

__device__ __forceinline__ void run_phase(const Params& p, int ph, LAS unsigned char* lds, int wv) {
    if (ph == NPH - 1) { final_phase(p, wv); return; }
    const int layer = ph / NSLOT, k = ph - layer * NSLOT, j = layer >> 1; const bool ssd = !(layer & 1);
    bf16_t* xb = (bf16_t*)(p.ws + WS_XB); float* ss = (float*)(p.ws + WS_SS);
    const int kk = k;
    EpiAll E{}; E.ss = ss; E.rsp = (const float*)(p.ws + WS_RS); E.x = p.out; E.dt = (float*)(p.ws + WS_DT); E.dt_bias = p.ssd_dt_bias + j * NH_; E.dt_tile = -1; E.scale = 1.0f;
    const bf16_t* A = xb; const bf16_t* Bt = nullptr; int N = 0, K = D_; bool gemm = true;
    switch (kk) {
    case 1: case 9: E.mode = 0; E.o0 = (bf16_t*)(p.ws + WS_R1); E.ld0 = FF_; Bt = (const bf16_t*)(p.ws + (kk == 1 ? WS_GU1 : WS_GU2)); N = 2 * FF_; break;
    case 2: case 10: E.mode = 1; E.o0 = xb; E.scale = 0.5f; A = (const bf16_t*)(p.ws + WS_R1); Bt = (const bf16_t*)(p.ws + (kk == 2 ? WS_D1 : WS_D2)); N = D_; K = FF_; break;
    case 3: E.mode = 2; Bt = (const bf16_t*)(p.ws + WS_MIN);
            if (ssd) { E.o0 = (bf16_t*)(p.ws + WS_R1); E.ld0 = DI_; E.nt0 = 8; E.o1 = (bf16_t*)(p.ws + WS_R2); E.ld1 = CONVD_; N = DI_ + CONVD_; }
            else { E.o0 = (bf16_t*)(p.ws + WS_R2); E.ld0 = CONVD_; E.nt0 = 12; E.o1 = E.o0; E.ld1 = CONVD_; N = CONVD_; } break;
    case 8: E.mode = 1; E.o0 = xb; A = (const bf16_t*)(p.ws + WS_R1); Bt = (const bf16_t*)(p.ws + WS_MOUT); N = D_; K = ssd ? DI_ : D_; break;
    default: gemm = false; break;
    }
    if (gemm) { run_gemm(lds, A, Bt, N, K, E, wv); if (kk == 3 && ssd) ssd_dt_phase(p, j, wv); return; }
    switch (kk) {
    case 0: prep_phase(p, layer, lds, wv); break;
    case 4: if (ssd) { ssd_conv_phase(p, j, wv); ssd_acs_phase(p, j, wv); } else sc_conv_phase(p, j, wv); break;
    case 5: if (ssd) ssd_states_phase(p, lds, wv); break;
    case 6: if (ssd) ssd_cscan_phase(p, wv); break;
    case 7: if (ssd) ssd_yout_phase(p, j, lds, wv); break;
    }
}

__global__ __launch_bounds__(512, 2) void mega(Params p) {
    extern __shared__ __attribute__((aligned(16))) unsigned char shm[];
    LAS unsigned char* lds = (LAS unsigned char*)shm;
    cg::grid_group grid = cg::this_grid();
    const int wv = __builtin_amdgcn_readfirstlane((int)(threadIdx.x >> 6));
    const bool t0 = (threadIdx.x == 0);
    if (threadIdx.x < 16) ((LAS unsigned*)(lds + LDS_CTL))[threadIdx.x] = 0u;
    __syncthreads();
    XcdBarrier xb = xcd_barrier_post((unsigned*)(p.ws + WS_BAR), (volatile LAS unsigned*)(lds + LDS_CTL), t0);
    bool first = true;
    for (int ph = p.ph_lo; ph < p.ph_hi; ++ph) {
        if (!phase_active(ph)) continue;
        { const int k = ph % NSLOT; if (ph < NPH - 1 && (k == 3 || k == 9)) { rs_phase(p, wv); xcd_barrier(xb, fresh_tid(wv) == 0); } }
        run_phase(p, ph, lds, wv);
        if (ph + 1 < p.ph_hi) {
            if (first) { __syncthreads(); grid.sync(); first = false; }
            else xcd_barrier(xb, fresh_tid(wv) == 0);
        }
    }
}

extern "C" void kernel_launch(void* const* d_in, const int* in_sizes, int n_in, void* d_out, int out_size, void* d_ws, size_t ws_size, hipStream_t stream) {
    static int grid = 0;
    if (grid == 0) {
        int dev = 0, cus = 0, per_cu = 0;
        hipGetDevice(&dev); hipDeviceGetAttribute(&cus, hipDeviceAttributeMultiprocessorCount, dev);
        hipFuncSetAttribute((const void*)mega, hipFuncAttributeMaxDynamicSharedMemorySize, LDS_BYTES);
        hipOccupancyMaxActiveBlocksPerMultiprocessor(&per_cu, (const void*)mega, 512, LDS_BYTES);
        if (per_cu < 1) per_cu = 1;
        grid = cus * per_cu;
        if (ws_size < WS_END) fprintf(stderr, "kernel_launch: workspace too small: %zu < %zu\n", ws_size, (size_t)WS_END);
        (void)hipGetLastError();
    }
    (void)hipMemsetAsync((unsigned char*)d_ws + WS_BAR, 0, 16384, stream);
    Params p{};
    p.x = (const float*)d_in[0]; p.norm_w = (const float*)d_in[1]; p.wg = (const float*)d_in[2]; p.wu = (const float*)d_in[3]; p.wd = (const float*)d_in[4];
    p.ssd_w_in = (const float*)d_in[5]; p.ssd_conv_w = (const float*)d_in[6]; p.ssd_conv_b = (const float*)d_in[7]; p.ssd_dt_bias = (const float*)d_in[8];
    p.ssd_a_log = (const float*)d_in[9]; p.ssd_d = (const float*)d_in[10]; p.ssd_norm_w = (const float*)d_in[11]; p.ssd_w_out = (const float*)d_in[12];
    p.sc_w_in = (const float*)d_in[13]; p.sc_conv_w = (const float*)d_in[14]; p.sc_w_out = (const float*)d_in[15]; p.final_w = (const float*)d_in[16];
    p.out = (float*)d_out; p.ws = (unsigned char*)d_ws;
#if ONE_LAUNCH
    p.ph_lo = 0; p.ph_hi = NPH;
    void* args[] = {&p};
    hipError_t e = hipLaunchCooperativeKernel((const void*)mega, dim3(grid), dim3(512), args, LDS_BYTES, stream);
    if (e != hipSuccess) fprintf(stderr, "cooperative launch failed: %s (grid %d)\n", hipGetErrorString(e), grid);
#else
    for (int ph = 0; ph < NPH; ++ph) { if (!phase_active(ph)) continue; p.ph_lo = ph; p.ph_hi = ph + 1; hipLaunchKernelGGL(mega, dim3(grid), dim3(512), LDS_BYTES, stream, p); }
#endif
}
```

```cpp
#include <hip/hip_runtime.h>
#include <hip/hip_cooperative_groups.h>
#include <cstdio>
namespace cg = cooperative_groups;
#ifndef ONE_LAUNCH
#define ONE_LAUNCH 1
#endif
__device__ __forceinline__ int fresh_tid(int wv) { unsigned m = ~0u; asm volatile("" : "+s"(m)); const int lane = (int)__builtin_amdgcn_mbcnt_hi(m, __builtin_amdgcn_mbcnt_lo(m, 0u)); return wv * 64 + lane; }
__device__ __forceinline__ int bid_opaque() { int b = blockIdx.x; asm volatile("" : "+s"(b)); return b; }
namespace pg8 {
#define PG8_LAS __attribute__((address_space(3)))
typedef unsigned short bf16_t;
typedef short bf16x8 __attribute__((ext_vector_type(8)));
typedef float f32x4 __attribute__((ext_vector_type(4)));
typedef unsigned u32x4 __attribute__((ext_vector_type(4)));
constexpr int BM = 256, BK = 64, HALF = 128, HTB = HALF * BK * 2  , STAGE_BYTES = 8 * HTB, NXCD = 8, WGM = 8;

__host__ __device__ __forceinline__ int lds_byte(int r, int c) { const int st = (r >> 4) * 2 + (c >> 5), rr = r & 15, cc = c & 31, ob = rr * 64 + cc * 2; return st * 1024 + (ob ^ (((ob >> 9) & 1) << 5)); }
__host__ __device__ __forceinline__ void stage_rc(int b, int& R, int& C) { const int st = b / 1024, sb = b % 1024, swz = sb ^ (((sb >> 9) & 1) << 5); R = (st >> 1) * 16 + swz / 64; C = (st & 1) * 32 + (swz % 64) / 2; }
__host__ __device__ __forceinline__ int perm32(int rho) { const int n = rho >> 4, i = rho & 15; return 8 * (i >> 2) + 4 * n + (i & 3); }

struct Unit { int pm, pn; };
struct Gemm { const bf16_t* A; const bf16_t* Bt; int M, N, K; };
struct StaticOrder {
    int nM, nN, nwg, G, c;
    __host__ __device__ void init(int M, int N, int G_, int c_) { nM = M / BM; nN = N / BM; nwg = nM * nN; G = G_; c = c_; }
    __host__ __device__ bool next(int i, Unit& u) const {
        const long L = (long)i * G + c; if (L >= nwg) return false;
        int wgid = (int)L; { const int q = nwg / NXCD, r = nwg % NXCD, xcd = wgid % NXCD, off = wgid / NXCD; wgid = (xcd < r ? xcd * (q + 1) : r * (q + 1) + (xcd - r) * q) + off; }
        const int nig = WGM * nN, gid = wgid / nig, fm = gid * WGM, gsz = (nM - fm) < WGM ? (nM - fm) : WGM;
        u.pm = fm + ((wgid % nig) % gsz); u.pn = (wgid % nig) / gsz; return true;
    }
    __device__ __forceinline__ void a_ready(const Unit&) const {}
    __device__ __forceinline__ void done(const Unit&) const {}
};
typedef float f32x2_t __attribute__((ext_vector_type(2)));
typedef __bf16 bf16x2_t __attribute__((ext_vector_type(2)));
__device__ __forceinline__ unsigned cvt_pk_bf16(float lo, float hi) { const f32x2_t f = {lo, hi}; const bf16x2_t b = __builtin_convertvector(f, bf16x2_t); return __builtin_bit_cast(unsigned, b); }
template <class Epi, class Sched, bool STAMP = false>
__device__ __forceinline__ void gemm_phase(PG8_LAS unsigned char* lds, const Gemm g, const Sched& S, const Epi& E, unsigned long long* stamps, int wv) {
    const int tid = fresh_tid(wv), wid = __builtin_amdgcn_readfirstlane(tid >> 6), lane = tid & 63, wr = wid >> 2, wc = wid & 3, fr = lane & 15, fq = lane >> 4;
    const int K = g.K, nt = K / BK;
    int ts_lo = 0, ts_hi = 0, nts = 0; const unsigned long long rt_entry = STAMP ? (unsigned long long)wall_clock64() : 0ull;
#define PG8_STAMP() do { if (STAMP && wid == 0 && nts < 64) { const unsigned long long _c = (unsigned long long)clock64(); \
        ts_lo = (lane == nts) ? (int)(unsigned)_c : ts_lo; ts_hi = (lane == nts) ? (int)(unsigned)(_c >> 32) : ts_hi; ++nts; } } while (0)
    PG8_STAMP();
    unsigned voffA[2], voffB[2];
#pragma unroll
    for (int i = 0; i < 2; ++i) { int R, C; stage_rc(tid * 16 + i * 8192, R, C); const int Rb = Epi::PERM ? ((R & ~31) + perm32(R & 31)) : R;
        voffA[i] = (unsigned)(R * K + C) * 2u; voffB[i] = (unsigned)(Rb * K + C) * 2u; }
    const size_t kstep = (size_t)(BK * 2);
    const size_t hstep = (size_t)HALF * K * 2;
    const size_t tstep = 2 * hstep;
    const unsigned ldsw = (unsigned)wid * 1024u;
    const int aoff = lds_byte(wr * 64 + fr, fq * 8), boff = lds_byte(wc * 32 + fr, fq * 8);
#define PG8_SA(b, h) (((b) * 2 + (h)) * HTB)
#define PG8_SB(b, h) ((4 + (b) * 2 + (h)) * HTB)
#define PG8_STAGE(bufoff, gbase, voff) do { _Pragma("unroll") for (int _i = 0; _i < 2; ++_i) \
        __builtin_amdgcn_global_load_lds((const unsigned*)((const char*)(gbase) + (voff)[_i]), (PG8_LAS unsigned*)(lds + (bufoff) + ldsw + _i * 8192), 16, 0, 0); } while (0)
#define PG8_LDA(dst, b, h) do { _Pragma("unroll") for (int m = 0; m < 4; ++m) _Pragma("unroll") for (int k = 0; k < 2; ++k) dst[m][k] = *(const PG8_LAS bf16x8*)(lds + PG8_SA(b, h) + aoff + m * 2048 + k * 1024); } while (0)
#define PG8_LDB(dst, b, h) do { _Pragma("unroll") for (int n = 0; n < 2; ++n) _Pragma("unroll") for (int k = 0; k < 2; ++k) dst[n][k] = *(const PG8_LAS bf16x8*)(lds + PG8_SB(b, h) + boff + n * 2048 + k * 1024); } while (0)
#define PG8_MMA(ai, bj, At, Bt) do { __builtin_amdgcn_s_setprio(1); _Pragma("unroll") for (int m = 0; m < 4; ++m) _Pragma("unroll") for (int n = 0; n < 2; ++n) _Pragma("unroll") for (int k = 0; k < 2; ++k) \
        acc[ai][bj][m][n] = __builtin_amdgcn_mfma_f32_16x16x32_bf16(Bt[n][k], At[m][k], acc[ai][bj][m][n], 0, 0, 0); __builtin_amdgcn_s_setprio(0); } while (0)
#define PG8_WAIT_V(n) asm volatile("s_waitcnt vmcnt(" #n ")" ::: "memory")
#define PG8_WAIT_L(n) asm volatile("s_waitcnt lgkmcnt(" #n ")" ::: "memory")
#define PG8_BAR __builtin_amdgcn_s_barrier()
#define PG8_SCHED __builtin_amdgcn_sched_barrier(0)
    Unit cur, nxt; int ui = 0;
    if (!S.next(0, cur)) return;
    f32x4 acc[2][2][4][2];
#pragma unroll
    for (int a = 0; a < 2; ++a)
#pragma unroll
        for (int b = 0; b < 2; ++b)
#pragma unroll
            for (int m = 0; m < 4; ++m)
#pragma unroll
                for (int n = 0; n < 2; ++n) acc[a][b][m][n] = (f32x4){0.f, 0.f, 0.f, 0.f};
    bf16x8 At[4][2], B0[2][2], B1[2][2];
    const char* cA = (const char*)g.A + (size_t)cur.pm * tstep; const char* cB = (const char*)g.Bt + (size_t)cur.pn * tstep;
    S.a_ready(cur);
    PG8_STAGE(PG8_SB(0, 0), cB, voffB); PG8_STAGE(PG8_SB(0, 1), cB + hstep, voffB); PG8_STAGE(PG8_SA(0, 0), cA, voffA); PG8_STAGE(PG8_SA(0, 1), cA + hstep, voffA);
    if (wr == 1) PG8_BAR;
    PG8_WAIT_V(2); PG8_BAR;
    PG8_STAGE(PG8_SB(1, 0), cB + kstep, voffB); PG8_STAGE(PG8_SA(1, 0), cA + kstep, voffA); PG8_STAGE(PG8_SB(1, 1), cB + hstep + kstep, voffB);
    PG8_WAIT_V(6); PG8_BAR;
    PG8_STAMP();
    for (;;) {
        const bool has_next = S.next(ui + 1, nxt);
        const char* nA = has_next ? (const char*)g.A + (size_t)nxt.pm * tstep : cA; const char* nB = has_next ? (const char*)g.Bt + (size_t)nxt.pn * tstep : cB;
        for (int t = 0; t < nt; t += 2) {
            const bool last = (t == nt - 2);
            const char* a1 = cA + (size_t)(t + 1) * kstep;
            const char* a2 = last ? nA : cA + (size_t)(t + 2) * kstep; const char* b2 = last ? nB : cB + (size_t)(t + 2) * kstep;
            const char* a3 = a2 + kstep; const char* b3 = b2 + kstep;
            if (last && has_next) S.a_ready(nxt);
            PG8_LDB(B0, 0, 0); PG8_LDB(B1, 0, 1); PG8_SCHED; PG8_LDA(At, 0, 0); PG8_STAGE(PG8_SA(1, 1), a1 + hstep, voffA);
            PG8_WAIT_V(8); PG8_WAIT_L(0); PG8_BAR; PG8_MMA(0, 0, At, B0); PG8_MMA(0, 1, At, B1); PG8_BAR; PG8_SCHED;
            PG8_LDA(At, 0, 1); PG8_STAGE(PG8_SB(0, 0), b2, voffB); PG8_STAGE(PG8_SB(0, 1), b2 + hstep, voffB); PG8_STAGE(PG8_SA(0, 0), a2, voffA);
            PG8_WAIT_V(8); PG8_WAIT_L(0); PG8_BAR; PG8_MMA(1, 0, At, B0); PG8_MMA(1, 1, At, B1); PG8_BAR; PG8_SCHED;
            PG8_LDB(B0, 1, 0); PG8_LDB(B1, 1, 1); PG8_SCHED; PG8_LDA(At, 1, 0); PG8_STAGE(PG8_SA(0, 1), a2 + hstep, voffA);
            PG8_WAIT_V(8); PG8_WAIT_L(0); PG8_BAR; PG8_MMA(0, 0, At, B0); PG8_MMA(0, 1, At, B1); PG8_BAR; PG8_SCHED;
            PG8_LDA(At, 1, 1); PG8_STAGE(PG8_SB(1, 0), b3, voffB); PG8_STAGE(PG8_SB(1, 1), b3 + hstep, voffB); PG8_STAGE(PG8_SA(1, 0), a3, voffA);
            PG8_WAIT_V(8); PG8_WAIT_L(0); PG8_BAR; PG8_MMA(1, 0, At, B0); PG8_MMA(1, 1, At, B1); PG8_BAR; PG8_SCHED;
        }
        PG8_STAMP();
        if (wr == 0) PG8_BAR;
        if constexpr (!Epi::AFTER_DRAIN) { E(acc, cur, wr, wc, fr, fq); S.done(cur); }
        PG8_STAMP();
        if (!has_next) break;
#pragma unroll
        for (int a = 0; a < 2; ++a)
#pragma unroll
            for (int b = 0; b < 2; ++b)
#pragma unroll
                for (int m = 0; m < 4; ++m)
#pragma unroll
                    for (int n = 0; n < 2; ++n) acc[a][b][m][n] = (f32x4){0.f, 0.f, 0.f, 0.f};
        cur = nxt; cA = nA; cB = nB; ++ui;
        if (wr == 1) PG8_BAR;
    }
    PG8_WAIT_V(0);
    PG8_BAR;
    if constexpr (Epi::AFTER_DRAIN) { E.fused(acc, cur, wr, wc, fr, fq, lds, wid, lane); S.done(cur); }
    PG8_STAMP();
    if (STAMP && wid == 0) { stamps[lane] = lane < nts ? (((unsigned long long)(unsigned)ts_hi << 32) | (unsigned)ts_lo) : 0ull;
        if (lane == 62) stamps[62] = rt_entry; if (lane == 63) stamps[63] = (unsigned long long)wall_clock64(); }
#undef PG8_STAMP
#undef PG8_SA
#undef PG8_SB
#undef PG8_STAGE
#undef PG8_LDA
#undef PG8_LDB
#undef PG8_MMA
#undef PG8_WAIT_V
#undef PG8_WAIT_L
#undef PG8_BAR
#undef PG8_SCHED
}
}
#define LAS __attribute__((address_space(3)))
using pg8::bf16_t; using pg8::f32x4; using pg8::u32x4; using pg8::cvt_pk_bf16;
constexpr int S_ = 16384, D_ = 1024, FF_ = 2816, DI_ = 2048, NH_ = 32, CONVD_ = 3072, INP_ = 5376, INSRC_ = 5152;
constexpr float EPS_ = 1e-5f;
constexpr int LDS_CTL = 131072, LDS_BYTES = LDS_CTL + 64;
constexpr int NSLOT = 11, NPH = 4 * NSLOT + 1;

constexpr size_t SZ_GU = (size_t)2 * FF_ * D_ * 2, SZ_D = (size_t)D_ * FF_ * 2, SZ_MIN = (size_t)INP_ * D_ * 2, SZ_MOUT = (size_t)D_ * DI_ * 2;
constexpr size_t WS_GU1 = 0, WS_D1 = WS_GU1 + SZ_GU, WS_GU2 = WS_D1 + SZ_D, WS_D2 = WS_GU2 + SZ_GU, WS_MIN = WS_D2 + SZ_D, WS_MOUT = WS_MIN + SZ_MIN;
constexpr size_t WS_XB = WS_MOUT + SZ_MOUT;
constexpr size_t WS_SS = WS_XB + (size_t)S_ * D_ * 2;
constexpr size_t WS_DT = WS_SS + (size_t)S_ * 16 * 4;
constexpr size_t WS_R1 = WS_DT + (size_t)S_ * 32 * 4;
constexpr size_t WS_R2 = WS_R1 + (size_t)S_ * FF_ * 2;
constexpr size_t WS_R3 = WS_R2 + (size_t)S_ * CONVD_ * 2;
constexpr size_t WS_ACS = WS_R3 + (size_t)S_ * CONVD_ * 2;
constexpr size_t WS_DTT = WS_ACS + (size_t)S_ * 32 * 4;
constexpr size_t WS_RS = WS_DTT + (size_t)S_ * 32 * 4;
constexpr size_t WS_BAR = WS_RS + (size_t)S_ * 4;
constexpr size_t WS_END = WS_BAR + 16384;
constexpr size_t WS_ST = WS_R2;

struct Params {
    const float *x, *norm_w, *wg, *wu, *wd, *ssd_w_in, *ssd_conv_w, *ssd_conv_b, *ssd_dt_bias, *ssd_a_log, *ssd_d, *ssd_norm_w, *ssd_w_out, *sc_w_in, *sc_conv_w, *sc_w_out, *final_w;
    float* out; unsigned char* ws; int ph_lo, ph_hi;
};

__device__ __forceinline__ float bflo(unsigned w) { return __uint_as_float(w << 16); }
__device__ __forceinline__ float bfhi(unsigned w) { return __uint_as_float(w & 0xffff0000u); }
__device__ __forceinline__ float wave_sum(float v) {
#pragma unroll
    for (int o = 1; o < 64; o <<= 1) v += __shfl_xor(v, o);
    return v;
}
__device__ __forceinline__ float silu_f(float v) { return v * __builtin_amdgcn_rcpf(1.0f + __builtin_amdgcn_exp2f(v * -1.44269504089f)); }
__device__ __forceinline__ void unpack8(const u32x4 w, float (&f)[8]) { f[0] = bflo(w.x); f[1] = bfhi(w.x); f[2] = bflo(w.y); f[3] = bfhi(w.y); f[4] = bflo(w.z); f[5] = bfhi(w.z); f[6] = bflo(w.w); f[7] = bfhi(w.w); }

__device__ __forceinline__ int rs_index(int row) { return ((((row >> 8) * 2 + ((row >> 6) & 1)) * 16 + (row & 15)) << 3) + ((row >> 7) & 1) * 4 + ((row >> 4) & 3); }
#define XB_TMO      128
#define XB_XCNT(j)  (256  + 64 * (j))
#define XB_XSUB(j)  (1280 + 64 * (j))
#define XB_XGEN(j)  (2304 + 64 * (j))
#define XB_TOP      3328
#define XB_TOPGEN   3392
#define XCD_BAR_WORDS 3456
#define XB_SPIN_CAP (1u << 18)

__device__ __forceinline__ unsigned xb_ld(unsigned* p)              { return __hip_atomic_load(p, __ATOMIC_RELAXED, __HIP_MEMORY_SCOPE_AGENT); }
__device__ __forceinline__ unsigned xb_add(unsigned* p, unsigned v) { return __hip_atomic_fetch_add(p, v, __ATOMIC_RELAXED, __HIP_MEMORY_SCOPE_AGENT); }
__device__ __forceinline__ unsigned xb_xcc_id() { return (unsigned)__builtin_amdgcn_s_getreg((3 << 11) | 20) & 0xFu; }
#define XB_SPIN(cond, bar) do { unsigned _sp = 0; while (cond) { __builtin_amdgcn_s_sleep(1); \
    if ((++_sp & 255u) == 0u) { if (xb_ld(&(bar)[XB_TMO])) break; if (_sp > XB_SPIN_CAP) { atomicAdd(&(bar)[XB_TMO], 1u); break; } } } } while (0)

struct XcdBarrier {
    unsigned* bar; unsigned x;
    volatile LAS unsigned* st;
};

__device__ __forceinline__ XcdBarrier xcd_barrier_post(unsigned* bar, volatile LAS unsigned* st, bool t0) {
    XcdBarrier b; b.bar = bar; b.x = xb_xcc_id(); b.st = st;
    if (t0) (void)xb_add(&bar[XB_XCNT(b.x)], 1u);
    return b;
}
__device__ __forceinline__ void xcd_barrier_complete(unsigned* bar, unsigned x, unsigned& nloc, unsigned& nx) {
    const unsigned G = gridDim.x * gridDim.y * gridDim.z;
    unsigned sum, cnt, mine, sp = 0u;
    for (;;) {
        sum = 0u; cnt = 0u; mine = 0u;
#pragma unroll
        for (unsigned j = 0; j < 16; ++j) { const unsigned c = xb_ld(&bar[XB_XCNT(j)]); sum += c; cnt += (c > 0u) ? 1u : 0u; mine = (j == x) ? c : mine; }
        if (sum == G) break;
        __builtin_amdgcn_s_sleep(1);
        if ((++sp & 255u) == 0u) { if (xb_ld(&bar[XB_TMO])) break; if (sp > XB_SPIN_CAP) { atomicAdd(&bar[XB_TMO], 1u); break; } }
    }
    nloc = mine > 0u ? mine : 1u; nx = cnt > 0u ? cnt : 1u;
}

__device__ __forceinline__ void xcd_barrier(const XcdBarrier& b, bool t0) {
    asm volatile("s_waitcnt vmcnt(0)" ::: "memory");
    __syncthreads();
    if (t0) {
        unsigned* bar = b.bar;
        __builtin_amdgcn_s_waitcnt(0);
        unsigned nloc = b.st[0], nx = b.st[1];
        if (nloc == 0u) { xcd_barrier_complete(bar, b.x, nloc, nx); b.st[0] = nloc; b.st[1] = nx; }
        const unsigned old = xb_add(&bar[XB_XSUB(b.x)], 1u);
        const unsigned gen = old / nloc;
        if (old + 1u == (gen + 1u) * nloc) {
            __builtin_amdgcn_fence(__ATOMIC_RELEASE, "agent");
            asm volatile("s_waitcnt vmcnt(0)" ::: "memory");
            const unsigned og = xb_add(&bar[XB_TOP], 1u);
            const unsigned tg = og / nx;
            if (og + 1u == (tg + 1u) * nx) xb_add(&bar[XB_TOPGEN], 1u);
            else XB_SPIN(xb_ld(&bar[XB_TOPGEN]) == tg, bar);
            __builtin_amdgcn_fence(__ATOMIC_ACQUIRE, "agent");
            xb_add(&bar[XB_XGEN(b.x)], 1u);
            asm volatile("s_waitcnt vmcnt(0)" ::: "memory");
        } else {
            XB_SPIN(xb_ld(&bar[XB_XGEN(b.x)]) == gen, bar);
            __builtin_amdgcn_fence(__ATOMIC_ACQUIRE, "agent");
            asm volatile("s_waitcnt vmcnt(0)" ::: "memory");
        }
    }
    __syncthreads();
}

struct EpiAll {
    static constexpr bool PERM = true, AFTER_DRAIN = false;
    int mode;
    bf16_t* o0; int ld0, nt0; bf16_t* o1; int ld1;
    float* ss; float scale;
    const float* rsp;
    __device__ __forceinline__ void row_scales(int pm, int wr, int fr, float (&rs)[8]) const {
        const f32x4* q = (const f32x4*)(rsp + (((pm * 2 + wr) * 16 + fr) << 3)); const f32x4 a = q[0], b = q[1];
        rs[0] = a.x; rs[1] = a.y; rs[2] = a.z; rs[3] = a.w; rs[4] = b.x; rs[5] = b.y; rs[6] = b.z; rs[7] = b.w;
        rs[0] = __shfl_xor(rs[0], 16);
    }
    __device__ __forceinline__ void operator()(const f32x4 (&acc)[2][2][4][2], const pg8::Unit& u, int wr, int wc, int fr, int fq) const {
        const int row0 = u.pm * 256 + wr * 64 + fr;
        if (mode == 1) {
            const int col0 = u.pn * 256 + wc * 32 + 8 * fq;
#pragma unroll
            for (int ai = 0; ai < 2; ++ai) {
                bf16_t* xbase = o0 + (size_t)(row0 + ai * 128) * D_ + col0;
                u32x4 old[4][2];
#pragma unroll
                for (int m = 0; m < 4; ++m)
#pragma unroll
                    for (int bj = 0; bj < 2; ++bj) old[m][bj] = *(const u32x4*)(xbase + (size_t)m * 16 * D_ + bj * 128);
                u32x4 nw_[4][2]; float qq[4];
#pragma unroll
                for (int m = 0; m < 4; ++m) { float q = 0.f;
#pragma unroll
                    for (int bj = 0; bj < 2; ++bj) {
                        float xo[8]; unpack8(old[m][bj], xo);
                        f32x4 a = (f32x4){xo[0], xo[1], xo[2], xo[3]}, b = (f32x4){xo[4], xo[5], xo[6], xo[7]};
                        a = a + acc[ai][bj][m][0] * scale; b = b + acc[ai][bj][m][1] * scale;
                        q += (a.x * a.x + a.y * a.y) + (a.z * a.z + a.w * a.w) + (b.x * b.x + b.y * b.y) + (b.z * b.z + b.w * b.w);
                        u32x4 w; w.x = cvt_pk_bf16(a.x, a.y); w.y = cvt_pk_bf16(a.z, a.w); w.z = cvt_pk_bf16(b.x, b.y); w.w = cvt_pk_bf16(b.z, b.w);
                        nw_[m][bj] = w; }
                    q += __shfl_xor(q, 16); q += __shfl_xor(q, 32); qq[m] = q; }
#pragma unroll
                for (int m = 0; m < 4; ++m) {
#pragma unroll
                    for (int bj = 0; bj < 2; ++bj) *(u32x4*)(xbase + (size_t)m * 16 * D_ + bj * 128) = nw_[m][bj];
                    if (fq == 0) ss[(size_t)(row0 + ai * 128 + m * 16) * 16 + u.pn * 4 + wc] = qq[m]; }
            }
            return;
        }
        float rs[8]; row_scales(u.pm, wr, fr, rs);
        if (mode == 0) {
            const int col0 = u.pn * 128 + wc * 32 + 8 * fq;
#pragma unroll
            for (int ai = 0; ai < 2; ++ai)
#pragma unroll
                for (int m = 0; m < 4; ++m) {
                    const int row = row0 + ai * 128 + m * 16; const float r = rs[ai * 4 + m];
                    float o[8];
#pragma unroll
                    for (int n = 0; n < 2; ++n)
#pragma unroll
                        for (int j = 0; j < 4; ++j) { const float g = acc[ai][0][m][n][j] * r, v = acc[ai][1][m][n][j] * r; o[n * 4 + j] = silu_f(g) * v; }
                    u32x4 w; w.x = cvt_pk_bf16(o[0], o[1]); w.y = cvt_pk_bf16(o[2], o[3]); w.z = cvt_pk_bf16(o[4], o[5]); w.w = cvt_pk_bf16(o[6], o[7]);
                    *(u32x4*)(o0 + (size_t)row * ld0 + col0) = w; }
        } else {
            bf16_t* base; int ld, colt;
            if (u.pn < nt0) { base = o0; ld = ld0; colt = u.pn * 256; } else { base = o1; ld = ld1; colt = (u.pn - nt0) * 256; }
            const int col0 = colt + wc * 32 + 8 * fq;
#pragma unroll
            for (int ai = 0; ai < 2; ++ai)
#pragma unroll
                for (int m = 0; m < 4; ++m) {
                    const int row = row0 + ai * 128 + m * 16; const float r = rs[ai * 4 + m];
#pragma unroll
                    for (int bj = 0; bj < 2; ++bj) {
                        const f32x4 a = acc[ai][bj][m][0] * r, b = acc[ai][bj][m][1] * r;
                        u32x4 w; w.x = cvt_pk_bf16(a.x, a.y); w.y = cvt_pk_bf16(a.z, a.w); w.z = cvt_pk_bf16(b.x, b.y); w.w = cvt_pk_bf16(b.z, b.w);
                        *(u32x4*)(base + (size_t)row * ld + col0 + bj * 128) = w; } }
        }
    }
};

template <class Epi> __device__ __forceinline__ void run_gemm(LAS unsigned char* lds, const bf16_t* A, const bf16_t* Bt, int N, int K, const Epi& E, int wv) {
    pg8::Gemm g; g.A = A; g.Bt = Bt; g.M = S_; g.N = N; g.K = K;
    pg8::StaticOrder S; S.init(S_, N, (int)gridDim.x, (int)blockIdx.x);
    pg8::gemm_phase<Epi, pg8::StaticOrder, false>(lds, g, S, E, nullptr, wv);
}

__device__ __forceinline__ void tr_item(const float* W, int ldw, int k0, int scol0, const float* scale, bf16_t* WT, int K, int drow0, LAS float* scr, int lane) {
    float v[32];
    const float* wp = W + (size_t)(k0 + (lane >> 5)) * ldw + scol0 + (lane & 31);
#pragma unroll
    for (int i = 0; i < 32; ++i) v[i] = wp[(size_t)(2 * i) * ldw];
    if (scale) {
#pragma unroll
        for (int i = 0; i < 32; ++i) v[i] *= scale[k0 + 2 * i + (lane >> 5)]; }
#pragma unroll
    for (int i = 0; i < 32; ++i) scr[(2 * i + (lane >> 5)) * 33 + (lane & 31)] = v[i];
    asm volatile("s_waitcnt lgkmcnt(0)" ::: "memory");
    const int c = lane & 7;
#pragma unroll
    for (int j = 0; j < 4; ++j) { const int n = (lane >> 3) + 8 * j; const LAS float* s = scr + (8 * c) * 33 + n;
        u32x4 o; o.x = cvt_pk_bf16(s[0 * 33], s[1 * 33]); o.y = cvt_pk_bf16(s[2 * 33], s[3 * 33]); o.z = cvt_pk_bf16(s[4 * 33], s[5 * 33]); o.w = cvt_pk_bf16(s[6 * 33], s[7 * 33]);
        *(u32x4*)(WT + (size_t)(drow0 + n) * K + k0 + 8 * c) = o; }
    asm volatile("s_waitcnt lgkmcnt(0)" ::: "memory");
}

__device__ __forceinline__ void rs_phase(const Params& p, int wv) {
    const float* ss = (const float*)(p.ws + WS_SS); float* rsp = (float*)(p.ws + WS_RS);
    for (int t = bid_opaque() * 512 + fresh_tid(wv); t < S_ * 8; t += gridDim.x * 512) {
        const int row = t >> 3, part = t & 7; const float* q = ss + (size_t)row * 16 + 2 * part;
        float v = q[0] + q[1]; v += __shfl_xor(v, 1); v += __shfl_xor(v, 2); v += __shfl_xor(v, 4);
        if (part == 0) rsp[rs_index(row)] = rsqrtf(v * (1.0f / D_) + EPS_);
    }
}
__device__ __forceinline__ void prep_phase(const Params& p, int layer, LAS unsigned char* lds, int wv) {
    const int lane = fresh_tid(wv) & 63, wave = fresh_tid(wv) >> 6;
    LAS float* scr = (LAS float*)(lds + wave * 8448);
    const int gw = bid_opaque() * 8 + wave, NGW = gridDim.x * 8;
    const bool ssd = !(layer & 1); const int j = layer >> 1;
    const float* nw = p.norm_w + (size_t)layer * 3 * D_;
    constexpr int I_GU = (D_ / 64) * (FF_ / 32), I_D = (FF_ / 64) * (D_ / 32);
    const int nbin = ssd ? INSRC_ / 32 : CONVD_ / 32, I_MIN = (D_ / 64) * nbin, kout = ssd ? DI_ : D_, I_MOUT = (kout / 64) * (D_ / 32);
    const int total = 4 * I_GU + 2 * I_D + I_MIN + I_MOUT;
    for (int it = gw; it < total; it += NGW) {
        int r = it;
        if (r < 4 * I_GU) { const int which = r / I_GU; r -= which * I_GU; const int f = which >> 1, s = which & 1;
            const float* W = (s ? p.wu : p.wg) + (size_t)(layer * 2 + f) * D_ * FF_;
            const int kb = r / (FF_ / 32), nb = r - kb * (FF_ / 32), h0 = nb * 32, drow0 = 256 * (h0 >> 7) + 128 * s + (h0 & 127);
            tr_item(W, FF_, kb * 64, h0, nw + (f ? 2 * D_ : 0), (bf16_t*)(p.ws + (f ? WS_GU2 : WS_GU1)), D_, drow0, scr, lane); continue; }
        r -= 4 * I_GU;
        if (r < 2 * I_D) { const int f = r / I_D; r -= f * I_D;
            const float* W = p.wd + (size_t)(layer * 2 + f) * FF_ * D_;
            const int kb = r / (D_ / 32), nb = r - kb * (D_ / 32);
            tr_item(W, D_, kb * 64, nb * 32, nullptr, (bf16_t*)(p.ws + (f ? WS_D2 : WS_D1)), FF_, nb * 32, scr, lane); continue; }
        r -= 2 * I_D;
        if (r < I_MIN) { const int kb = r / nbin, nb = r - kb * nbin;
            const float* W = ssd ? p.ssd_w_in + (size_t)j * D_ * INSRC_ : p.sc_w_in + (size_t)j * D_ * CONVD_;
            tr_item(W, ssd ? INSRC_ : CONVD_, kb * 64, nb * 32, nw + D_, (bf16_t*)(p.ws + WS_MIN), D_, nb * 32, scr, lane); continue; }
        r -= I_MIN;
        { const int kb = r / (D_ / 32), nb = r - kb * (D_ / 32);
            const float* W = ssd ? p.ssd_w_out + (size_t)j * DI_ * D_ : p.sc_w_out + (size_t)j * D_ * D_;
            tr_item(W, D_, kb * 64, nb * 32, nullptr, (bf16_t*)(p.ws + WS_MOUT), kout, nb * 32, scr, lane); }
    }
    if (layer == 0) {
        bf16_t* xb = (bf16_t*)(p.ws + WS_XB); float* ss = (float*)(p.ws + WS_SS);
        for (int row = gw; row < S_; row += NGW) {
            const f32x4* xr = (const f32x4*)(p.x + (size_t)row * D_) + lane;
            unsigned long long* o8 = (unsigned long long*)(xb + (size_t)row * D_) + lane; float s = 0.f;
#pragma unroll
            for (int q = 0; q < 4; ++q) { const f32x4 v = xr[64 * q]; s += (v.x * v.x + v.y * v.y) + (v.z * v.z + v.w * v.w);
                o8[64 * q] = (unsigned long long)cvt_pk_bf16(v.x, v.y) | ((unsigned long long)cvt_pk_bf16(v.z, v.w) << 32); }
            s = wave_sum(s);
            if (lane < 16) ss[(size_t)row * 16 + lane] = lane == 0 ? s : 0.f;
            if (lane == 0) ((float*)(p.ws + WS_RS))[rs_index(row)] = rsqrtf(s * (1.0f / D_) + EPS_);
        }
    } else rs_phase(p, wv);
}

__device__ __forceinline__ u32x4 pack8(const float (&f)[8]) { u32x4 w; w.x = cvt_pk_bf16(f[0], f[1]); w.y = cvt_pk_bf16(f[2], f[3]); w.z = cvt_pk_bf16(f[4], f[5]); w.w = cvt_pk_bf16(f[6], f[7]); return w; }

__device__ __forceinline__ void sc_conv_phase(const Params& p, int j, int wv) {
    const bf16_t* bcu = (const bf16_t*)(p.ws + WS_R2); bf16_t* vo = (bf16_t*)(p.ws + WS_R1); const float* cw = p.sc_conv_w + (size_t)j * 3 * D_;
    const int nthr = gridDim.x * 512;
    for (int idx = bid_opaque() * 512 + fresh_tid(wv); idx < (S_ / 16) * 128; idx += nthr) {
        const int tb = idx >> 7, c = (idx & 127) * 8, t0 = tb * 16;
        float w[3][8];
#pragma unroll
        for (int k = 0; k < 3; ++k) { const f32x4 w0 = *(const f32x4*)(cw + k * D_ + c), w1 = *(const f32x4*)(cw + k * D_ + c + 4);
#pragma unroll
            for (int e = 0; e < 4; ++e) { w[k][e] = w0[e]; w[k][4 + e] = w1[e]; } }
        float h0[8], h1[8];
#pragma unroll
        for (int e = 0; e < 8; ++e) { h0[e] = 0.f; h1[e] = 0.f; }
        if (t0 > 0) { float a[8], b[8];
            unpack8(*(const u32x4*)(bcu + (size_t)(t0 - 2) * CONVD_ + D_ + c), a); unpack8(*(const u32x4*)(bcu + (size_t)(t0 - 2) * CONVD_ + 2 * D_ + c), b);
#pragma unroll
            for (int e = 0; e < 8; ++e) h0[e] = a[e] * b[e];
            unpack8(*(const u32x4*)(bcu + (size_t)(t0 - 1) * CONVD_ + D_ + c), a); unpack8(*(const u32x4*)(bcu + (size_t)(t0 - 1) * CONVD_ + 2 * D_ + c), b);
#pragma unroll
            for (int e = 0; e < 8; ++e) h1[e] = a[e] * b[e]; }
        const bf16_t* row = bcu + (size_t)t0 * CONVD_ + c; bf16_t* orow = vo + (size_t)t0 * D_ + c;
#pragma unroll 8
        for (int r = 0; r < 16; ++r) {
            float bg[8], cgv[8], uv[8], o[8];
            unpack8(*(const u32x4*)(row + (size_t)r * CONVD_), bg); unpack8(*(const u32x4*)(row + (size_t)r * CONVD_ + D_), cgv); unpack8(*(const u32x4*)(row + (size_t)r * CONVD_ + 2 * D_), uv);
#pragma unroll
            for (int e = 0; e < 8; ++e) { const float cu = cgv[e] * uv[e]; o[e] = bg[e] * (w[0][e] * h0[e] + w[1][e] * h1[e] + w[2][e] * cu); h0[e] = h1[e]; h1[e] = cu; }
            *(u32x4*)(orow + (size_t)r * D_) = pack8(o);
        }
    }
}
__device__ __forceinline__ void ssd_conv_phase(const Params& p, int j, int wv) {
    const bf16_t* raw = (const bf16_t*)(p.ws + WS_R2); bf16_t* xo = (bf16_t*)(p.ws + WS_R3);
    const float* cw = p.ssd_conv_w + (size_t)j * 4 * CONVD_; const float* cb = p.ssd_conv_b + (size_t)j * CONVD_;
    const int nthr = gridDim.x * 512;
    for (int idx = bid_opaque() * 512 + fresh_tid(wv); idx < (S_ / 64) * 384; idx += nthr) {
        const int tb = idx / 384, c = (idx - tb * 384) * 8, t0 = tb * 64;
        float w[4][8], bias[8];
#pragma unroll
        for (int k = 0; k < 4; ++k) { const f32x4 w0 = *(const f32x4*)(cw + k * CONVD_ + c), w1 = *(const f32x4*)(cw + k * CONVD_ + c + 4);
#pragma unroll
            for (int e = 0; e < 4; ++e) { w[k][e] = w0[e]; w[k][4 + e] = w1[e]; } }
        { const f32x4 b0 = *(const f32x4*)(cb + c), b1 = *(const f32x4*)(cb + c + 4);
#pragma unroll
          for (int e = 0; e < 4; ++e) { bias[e] = b0[e]; bias[4 + e] = b1[e]; } }
        float h0[8], h1[8], h2[8];
#pragma unroll
        for (int e = 0; e < 8; ++e) { h0[e] = 0.f; h1[e] = 0.f; h2[e] = 0.f; }
        if (t0 > 0) { unpack8(*(const u32x4*)(raw + (size_t)(t0 - 3) * CONVD_ + c), h0); unpack8(*(const u32x4*)(raw + (size_t)(t0 - 2) * CONVD_ + c), h1); unpack8(*(const u32x4*)(raw + (size_t)(t0 - 1) * CONVD_ + c), h2); }
        const bf16_t* row = raw + (size_t)t0 * CONVD_ + c; bf16_t* orow = xo + (size_t)t0 * CONVD_ + c;
#pragma unroll 8
        for (int r = 0; r < 64; ++r) {
            float v[8], o[8]; unpack8(*(const u32x4*)(row + (size_t)r * CONVD_), v);
#pragma unroll
            for (int e = 0; e < 8; ++e) { o[e] = silu_f(bias[e] + w[0][e] * h0[e] + w[1][e] * h1[e] + w[2][e] * h2[e] + w[3][e] * v[e]); h0[e] = h1[e]; h1[e] = h2[e]; h2[e] = v[e]; }
            *(u32x4*)(orow + (size_t)r * CONVD_) = pack8(o);
        }
    }
}
__device__ __forceinline__ void ssd_dt_phase(const Params& p, int j, int wv) {
    const int tid = fresh_tid(wv), lane = tid & 63, wave = tid >> 6, fr = lane & 15, fq = lane >> 4;
    const bf16_t* xb = (const bf16_t*)(p.ws + WS_XB); const bf16_t* wdt = (const bf16_t*)(p.ws + WS_MIN) + (size_t)5120 * D_; const float* ss = (const float*)(p.ws + WS_SS); float* dt = (float*)(p.ws + WS_DT);
    const float* bias = p.ssd_dt_bias + j * NH_;
    for (int tile = bid_opaque() * 8 + wave; tile < S_ / 16; tile += gridDim.x * 8) {
        const int r0 = tile * 16;
        const bf16_t* ap = xb + (size_t)(r0 + fr) * D_ + 8 * fq; const bf16_t* bp = wdt + (size_t)fr * D_ + 8 * fq;
        f32x4 acc0 = (f32x4){0.f, 0.f, 0.f, 0.f}, acc1 = acc0;
#pragma unroll 8
        for (int ks = 0; ks < 32; ++ks) {
            const pg8::bf16x8 a = *(const pg8::bf16x8*)(ap + ks * 32), b0 = *(const pg8::bf16x8*)(bp + ks * 32), b1 = *(const pg8::bf16x8*)(bp + 16 * D_ + ks * 32);
            acc0 = __builtin_amdgcn_mfma_f32_16x16x32_bf16(b0, a, acc0, 0, 0, 0); acc1 = __builtin_amdgcn_mfma_f32_16x16x32_bf16(b1, a, acc1, 0, 0, 0);
        }
        const float rs = ((const float*)(p.ws + WS_RS))[rs_index(r0 + fr)];
        const f32x4 bb0 = *(const f32x4*)(bias + 4 * fq), bb1 = *(const f32x4*)(bias + 16 + 4 * fq);
        f32x4 a = acc0 * rs + bb0, b = acc1 * rs + bb1;
#pragma unroll
        for (int e = 0; e < 4; ++e) { a[e] = fmaxf(a[e], 0.f) + log1pf(__expf(-fabsf(a[e]))); b[e] = fmaxf(b[e], 0.f) + log1pf(__expf(-fabsf(b[e]))); }
        float* o = dt + (size_t)(r0 + fr) * 32 + 4 * fq; *(f32x4*)o = a; *(f32x4*)(o + 16) = b;
    }
}
__device__ __forceinline__ void ssd_acs_phase(const Params& p, int j, int wv) {
    const float* dt = (const float*)(p.ws + WS_DT); float* acsT = (float*)(p.ws + WS_ACS); float* dtT = (float*)(p.ws + WS_DTT);
    const int tid = fresh_tid(wv), lane = tid & 63, wave = tid >> 6;
    for (int it = bid_opaque() * 8 + wave; it < 128 * NH_; it += gridDim.x * 8) {
        const int c = it >> 5, h = it & 31; const float a = -__expf(p.ssd_a_log[j * NH_ + h]);
        const size_t t0 = (size_t)c * 128 + 2 * lane; const float d0 = dt[t0 * 32 + h], d1 = dt[(t0 + 1) * 32 + h];
        const float v0 = d0 * a, v1 = d1 * a; float s = v0 + v1;
#pragma unroll
        for (int o = 1; o < 64; o <<= 1) { const float t = __shfl_up(s, o); if (lane >= o) s += t; }
        const float ex = s - (v0 + v1); const size_t o = (size_t)it * 128 + 2 * lane;
        acsT[o] = ex + v0; acsT[o + 1] = ex + v0 + v1; dtT[o] = d0; dtT[o + 1] = d1;
    }
}
typedef short s16x4 __attribute__((ext_vector_type(4)));
__device__ __forceinline__ pg8::bf16x8 tr8(LAS unsigned char* lane_base, int off, int stride) {
    const s16x4 lo = __builtin_amdgcn_ds_read_tr16_b64_v4i16((LAS s16x4*)(lane_base + off));
    const s16x4 hi = __builtin_amdgcn_ds_read_tr16_b64_v4i16((LAS s16x4*)(lane_base + off + 4 * stride));
    pg8::bf16x8 r; r[0] = lo[0]; r[1] = lo[1]; r[2] = lo[2]; r[3] = lo[3]; r[4] = hi[0]; r[5] = hi[1]; r[6] = hi[2]; r[7] = hi[3]; return r;
}
__device__ __forceinline__ unsigned long long pack4(const f32x4 v) { return (unsigned long long)cvt_pk_bf16(v.x, v.y) | ((unsigned long long)cvt_pk_bf16(v.z, v.w) << 32); }
constexpr int XS_STRIDE = 1056, BS_STRIDE = 160, CS_STRIDE = 272;
__device__ __forceinline__ void ssd_states_phase(const Params& p, LAS unsigned char* lds, int wv) {
    const int tid = fresh_tid(wv), lane = tid & 63, wave = tid >> 6, fr = lane & 15, fq = lane >> 4;
    const bf16_t* xc = (const bf16_t*)(p.ws + WS_R3); const float* acsT = (const float*)(p.ws + WS_ACS); const float* dtT = (const float*)(p.ws + WS_DTT); bf16_t* st = (bf16_t*)(p.ws + WS_ST);
    LAS unsigned char* Xs = lds; LAS unsigned char* Bs = lds + 64 * XS_STRIDE; LAS float* wt = (LAS float*)(lds + 64 * XS_STRIDE + 64 * BS_STRIDE);
    LAS unsigned char* trB = Bs + (8 * fq + (fr >> 2)) * BS_STRIDE + 8 * (lane & 3);
    LAS unsigned char* trX = Xs + (8 * fq + (fr >> 2)) * XS_STRIDE + 8 * (lane & 3) + wave * 128;
#pragma unroll 1
    for (int it = bid_opaque(); it < 1024; it += gridDim.x) {
        const int item = 2 * (it % 512) + it / 512 * 0 + ((it >= 512) ? 1 : 0);
        const int c = item >> 3, g = (item >> 1) & 3, nh = item & 1;
        __syncthreads();
        for (int i = tid; i < 1024; i += 512) { const int e = i >> 7, l = i & 127; const size_t o = (size_t)(c * 32 + g * 8 + e) * 128; wt[i] = dtT[o + l] * __expf(acsT[o + 127] - acsT[o + l]); }
        f32x4 acc[4][4];
#pragma unroll
        for (int a = 0; a < 4; ++a)
#pragma unroll
            for (int b = 0; b < 4; ++b) acc[a][b] = (f32x4){0.f, 0.f, 0.f, 0.f};
#pragma unroll 1
        for (int half = 0; half < 2; ++half) {
            __syncthreads();
            {
                const int ch = tid & 63, r0 = tid >> 6;
                const bf16_t* xsrc = xc + (size_t)(c * 128 + half * 64 + r0) * CONVD_ + g * 512 + ch * 8;
                u32x4 v[8];
#pragma unroll
                for (int u = 0; u < 8; ++u) v[u] = *(const u32x4*)(xsrc + (size_t)u * 8 * CONVD_);
                const int rb = tid >> 3, cb8 = tid & 7;
                const u32x4 bv = *(const u32x4*)(xc + (size_t)(c * 128 + half * 64 + rb) * CONVD_ + DI_ + g * 128 + nh * 64 + cb8 * 8);
#pragma unroll
                for (int u = 0; u < 8; ++u) { float f[8]; unpack8(v[u], f); const float w = wt[(ch >> 3) * 128 + half * 64 + r0 + 8 * u];
#pragma unroll
                    for (int e = 0; e < 8; ++e) f[e] *= w;
                    *(LAS u32x4*)(Xs + (r0 + 8 * u) * XS_STRIDE + ch * 16) = pack8(f); }
                *(LAS u32x4*)(Bs + rb * BS_STRIDE + cb8 * 16) = bv;
            }
            __syncthreads();
#pragma unroll
            for (int ks = 0; ks < 2; ++ks) {
                pg8::bf16x8 ap[4];
#pragma unroll
                for (int pt = 0; pt < 4; ++pt) ap[pt] = tr8(trX, ks * 32 * XS_STRIDE + pt * 32, XS_STRIDE);
#pragma unroll
                for (int nt = 0; nt < 4; ++nt) { const pg8::bf16x8 bn = tr8(trB, ks * 32 * BS_STRIDE + nt * 32, BS_STRIDE);
#pragma unroll
                    for (int pt = 0; pt < 4; ++pt) acc[pt][nt] = __builtin_amdgcn_mfma_f32_16x16x32_bf16(bn, ap[pt], acc[pt][nt], 0, 0, 0); }
            }
        }
        bf16_t* so = st + (size_t)(c * 32 + g * 8 + wave) * 64 * 128 + fr * 128 + nh * 64 + 4 * fq;
#pragma unroll
        for (int pt = 0; pt < 4; ++pt)
#pragma unroll
            for (int nt = 0; nt < 4; ++nt) *(unsigned long long*)(so + pt * 16 * 128 + nt * 16) = pack4(acc[pt][nt]);
    }
}
__device__ __forceinline__ void ssd_cscan_phase(const Params& p, int wv) {
    const float* acsT = (const float*)(p.ws + WS_ACS); bf16_t* st = (bf16_t*)(p.ws + WS_ST);
    for (int e2 = bid_opaque() * 512 + fresh_tid(wv); e2 < NH_ * 4096; e2 += gridDim.x * 512) {
        const int h = e2 >> 12, rem = e2 & 4095; float r0 = 0.f, r1 = 0.f;
#pragma unroll 8
        for (int c = 0; c < 128; ++c) {
            unsigned* ptr = (unsigned*)(st + (size_t)(c * 32 + h) * 8192 + 2 * rem); const unsigned v = *ptr; const float d = __expf(acsT[(size_t)(c * 32 + h) * 128 + 127]);
            *ptr = cvt_pk_bf16(r0, r1); r0 = d * r0 + bflo(v); r1 = d * r1 + bfhi(v);
        }
    }
}
__device__ __forceinline__ void ssd_yout_phase(const Params& p, int j, LAS unsigned char* lds, int wv) {
    const int tid = fresh_tid(wv), lane = tid & 63, wave = tid >> 6, fr = lane & 15, fq = lane >> 4;
    const bf16_t* xc = (const bf16_t*)(p.ws + WS_R3); const float* acsT = (const float*)(p.ws + WS_ACS); const float* dtT = (const float*)(p.ws + WS_DTT);
    const bf16_t* st = (const bf16_t*)(p.ws + WS_ST); bf16_t* zg = (bf16_t*)(p.ws + WS_R1); const float* nw = p.ssd_norm_w + (size_t)j * DI_;
    LAS unsigned char* Cs = lds; LAS unsigned char* CBs = lds + 64 * CS_STRIDE; LAS unsigned char* Xs = lds + 128 * CS_STRIDE; LAS unsigned char* Bs = Xs;
    LAS float* acs_t = (LAS float*)(lds + 128 * CS_STRIDE + 64 * XS_STRIDE); LAS float* dt_t = acs_t + 1024; LAS float* red = dt_t + 1024;
    LAS unsigned char* cfb = Cs + fr * CS_STRIDE + 16 * fq;
    LAS unsigned char* bfb = Bs + fr * CS_STRIDE + 16 * fq;
    LAS unsigned char* cbr = CBs + fr * CS_STRIDE + 16 * fq;
    LAS unsigned char* trX = Xs + (8 * fq + (fr >> 2)) * XS_STRIDE + 8 * (lane & 3) + wave * 128;
    LAS float* redw = red + fr * 8;
#pragma unroll 1
    for (int it = bid_opaque(); it < 1024; it += gridDim.x) {
        const int item = 2 * (it % 512) + ((it >= 512) ? 1 : 0);
        const int c = item >> 3, g = (item >> 1) & 3, lh = item & 1, h = g * 8 + wave; const size_t trow = (size_t)c * 128; const int lbase = 64 * lh;
        LAS float* acl = acs_t + wave * 128 + lbase + fr;
        LAS float* acq = acs_t + wave * 128 + 8 * fq;
        __syncthreads();
        {
            const int r = tid >> 4, ch = tid & 15;
            const bf16_t* bsrc = xc + (trow + r) * CONVD_ + DI_ + g * 128 + ch * 8; const bf16_t* csrc = xc + (trow + lbase + r) * CONVD_ + DI_ + 512 + g * 128 + ch * 8;
            const size_t o = (size_t)(c * 32 + g * 8) * 128 + tid;
            u32x4 bv[4], cv[2];
#pragma unroll
            for (int u = 0; u < 4; ++u) bv[u] = (u < 2 || lh) ? *(const u32x4*)(bsrc + (size_t)u * 32 * CONVD_) : (u32x4){0u, 0u, 0u, 0u};
#pragma unroll
            for (int u = 0; u < 2; ++u) cv[u] = *(const u32x4*)(csrc + (size_t)u * 32 * CONVD_);
            const float a0 = acsT[o], a1 = acsT[o + 512], d0 = dtT[o], d1 = dtT[o + 512];
#pragma unroll
            for (int u = 0; u < 4; ++u) *(LAS u32x4*)(Bs + (r + 32 * u) * CS_STRIDE + ch * 16) = bv[u];
#pragma unroll
            for (int u = 0; u < 2; ++u) *(LAS u32x4*)(Cs + (r + 32 * u) * CS_STRIDE + ch * 16) = cv[u];
            acs_t[tid] = a0; acs_t[tid + 512] = a1; dt_t[tid] = d0; dt_t[tid + 512] = d1;
        }
        __syncthreads();
        {
            const int lt = wave & 3, sg = wave >> 2, mt = 4 * lh + lt;
            pg8::bf16x8 cf[4];
#pragma unroll
            for (int ks = 0; ks < 4; ++ks) cf[ks] = *(const LAS pg8::bf16x8*)(cfb + lt * 16 * CS_STRIDE + ks * 64);
#pragma unroll
            for (int si = 0; si < 4; ++si) {
                const int s8 = 4 * sg + si;
                if (s8 <= (mt | 1)) {
                    f32x4 a = (f32x4){0.f, 0.f, 0.f, 0.f};
#pragma unroll
                    for (int ks = 0; ks < 4; ++ks) { const pg8::bf16x8 bf = *(const LAS pg8::bf16x8*)(bfb + s8 * 16 * CS_STRIDE + ks * 64); a = __builtin_amdgcn_mfma_f32_16x16x32_bf16(bf, cf[ks], a, 0, 0, 0); }
                    *(LAS unsigned long long*)(CBs + (lt * 16 + fr) * CS_STRIDE + (s8 * 16 + 4 * fq) * 2) = pack4(a);
                }
            }
        }
        f32x4 acc[4][4];
#pragma unroll
        for (int a = 0; a < 4; ++a)
#pragma unroll
            for (int b = 0; b < 4; ++b) acc[a][b] = (f32x4){0.f, 0.f, 0.f, 0.f};
        {
            const bf16_t* pv = st + (size_t)(c * 32 + h) * 8192 + fr * 128 + 8 * fq;
#pragma unroll
            for (int ks = 0; ks < 4; ++ks) {
                pg8::bf16x8 pf[4];
#pragma unroll
                for (int pt = 0; pt < 4; ++pt) pf[pt] = *(const pg8::bf16x8*)(pv + pt * 16 * 128 + ks * 32);
#pragma unroll
                for (int lt = 0; lt < 4; ++lt) { const pg8::bf16x8 cf = *(const LAS pg8::bf16x8*)(cfb + lt * 16 * CS_STRIDE + ks * 64);
#pragma unroll
                    for (int pt = 0; pt < 4; ++pt) acc[lt][pt] = __builtin_amdgcn_mfma_f32_16x16x32_bf16(pf[pt], cf, acc[lt][pt], 0, 0, 0); }
            }
#pragma unroll
            for (int lt = 0; lt < 4; ++lt) { const float sc = __expf(acl[lt * 16]);
#pragma unroll
                for (int pt = 0; pt < 4; ++pt) acc[lt][pt] = acc[lt][pt] * sc; }
        }
#pragma unroll 1
        for (int half = 0; half <= lh; ++half) {
            __syncthreads();
            {
                const int ch = tid & 63, r0 = tid >> 6;
                const bf16_t* xsrc = xc + (trow + half * 64 + r0) * CONVD_ + g * 512 + ch * 8;
                u32x4 v[8];
#pragma unroll
                for (int u = 0; u < 8; ++u) v[u] = *(const u32x4*)(xsrc + (size_t)u * 8 * CONVD_);
#pragma unroll
                for (int u = 0; u < 8; ++u) { float f[8]; unpack8(v[u], f); const float w = dt_t[(ch >> 3) * 128 + half * 64 + r0 + 8 * u];
#pragma unroll
                    for (int e = 0; e < 8; ++e) f[e] *= w;
                    *(LAS u32x4*)(Xs + (r0 + 8 * u) * XS_STRIDE + ch * 16) = pack8(f); }
            }
            __syncthreads();
#pragma unroll
            for (int kk = 0; kk < 2; ++kk) {
                const int kt = 2 * half + kk;
                pg8::bf16x8 xf[4];
#pragma unroll
                for (int pt = 0; pt < 4; ++pt) xf[pt] = tr8(trX, kk * 32 * XS_STRIDE + pt * 32, XS_STRIDE);
                const f32x4 as0 = *(const LAS f32x4*)(acq + kt * 32), as1 = *(const LAS f32x4*)(acq + kt * 32 + 4);
                const float asv[8] = {as0.x, as0.y, as0.z, as0.w, as1.x, as1.y, as1.z, as1.w};
#pragma unroll
                for (int lt = 0; lt < 4; ++lt) {
                    const int mt = 4 * lh + lt;
                    if (mt >= 2 * kt) {
                        const int dl = mt * 16 + fr - kt * 32 - 8 * fq;
                        const float al = acl[lt * 16];
                        float cb[8]; unpack8(*(const LAS u32x4*)(cbr + lt * 16 * CS_STRIDE + kt * 64), cb);
#pragma unroll
                        for (int e = 0; e < 8; ++e) cb[e] = (e <= dl) ? cb[e] * __expf(fminf(al - asv[e], 0.f)) : 0.f;
                        const u32x4 pw = pack8(cb); const pg8::bf16x8 pfr = __builtin_bit_cast(pg8::bf16x8, pw);
#pragma unroll
                        for (int pt = 0; pt < 4; ++pt) acc[lt][pt] = __builtin_amdgcn_mfma_f32_16x16x32_bf16(xf[pt], pfr, acc[lt][pt], 0, 0, 0);
                    }
                }
            }
        }
        const float Dh = p.ssd_d[j * NH_ + h];
        const bf16_t* xrow = xc + (trow + lbase + fr) * CONVD_ + h * 64 + 4 * fq; bf16_t* zrow = zg + (trow + lbase + fr) * DI_ + h * 64 + 4 * fq;
#pragma unroll
        for (int lt = 0; lt < 4; ++lt) {
            float q = 0.f;
#pragma unroll
            for (int pt = 0; pt < 4; ++pt) {
                const unsigned long long xv = *(const unsigned long long*)(xrow + (size_t)lt * 16 * CONVD_ + pt * 16), zv = *(const unsigned long long*)(zrow + (size_t)lt * 16 * DI_ + pt * 16);
                const float x4[4] = {bflo((unsigned)xv), bfhi((unsigned)xv), bflo((unsigned)(xv >> 32)), bfhi((unsigned)(xv >> 32))};
                const float z4[4] = {bflo((unsigned)zv), bfhi((unsigned)zv), bflo((unsigned)(zv >> 32)), bfhi((unsigned)(zv >> 32))};
#pragma unroll
                for (int e = 0; e < 4; ++e) { const float y = (acc[lt][pt][e] + Dh * x4[e]) * silu_f(z4[e]); acc[lt][pt][e] = y; q += y * y; }
            }
            q += __shfl_xor(q, 16); q += __shfl_xor(q, 32);
            if (fq == 0) redw[lt * 128 + wave] = q;
        }
        __syncthreads();
        const float* nwl = nw + h * 64 + 4 * fq;
#pragma unroll
        for (int lt = 0; lt < 4; ++lt) {
            const f32x4 r0 = *(const LAS f32x4*)(redw + lt * 128), r1 = *(const LAS f32x4*)(redw + lt * 128 + 4);
            const float rs = rsqrtf((((r0.x + r0.y) + (r0.z + r0.w)) + ((r1.x + r1.y) + (r1.z + r1.w))) * (1.0f / 512.f) + EPS_);
#pragma unroll
            for (int pt = 0; pt < 4; ++pt) { const f32x4 w = *(const f32x4*)(nwl + pt * 16);
                *(unsigned long long*)(zrow + (size_t)lt * 16 * DI_ + pt * 16) = pack4(acc[lt][pt] * rs * w); }
        }
    }
}
__device__ __forceinline__ void final_phase(const Params& p, int wv) {
    const int tid = fresh_tid(wv), lane = tid & 63, wave = tid >> 6; const bf16_t* xb = (const bf16_t*)(p.ws + WS_XB);
    for (int row = bid_opaque() * 8 + wave; row < S_; row += gridDim.x * 8) {
        const u32x4* xr = (const u32x4*)(xb + (size_t)row * D_) + lane; f32x4* orow = (f32x4*)(p.out + (size_t)row * D_) + 2 * lane; const f32x4* wr = (const f32x4*)p.final_w + 2 * lane;
        float v[2][8]; float s = 0.f;
#pragma unroll
        for (int q = 0; q < 2; ++q) { unpack8(xr[64 * q], v[q]);
#pragma unroll
            for (int e = 0; e < 8; ++e) s += v[q][e] * v[q][e]; }
        const float rs = rsqrtf(wave_sum(s) * (1.0f / D_) + EPS_);
#pragma unroll
        for (int q = 0; q < 2; ++q) { const f32x4 w0 = wr[128 * q], w1 = wr[128 * q + 1];
            orow[128 * q] = (f32x4){v[q][0], v[q][1], v[q][2], v[q][3]} * rs * w0; orow[128 * q + 1] = (f32x4){v[q][4], v[q][5], v[q][6], v[q][7]} * rs * w1; }
    }
}

__host__ __device__ inline bool phase_active(int ph) { if (ph >= NPH - 1) return ph == NPH - 1; const int layer = ph / NSLOT, k = ph % NSLOT; return !((layer & 1) && (k >= 5 && k <= 7)); }

__device__ __forceinline__ void run_phase(const Params& p, int ph, LAS unsigned char* lds, int wv) {
    if (ph == NPH - 1) { final_phase(p, wv); return; }
    const int layer = ph / NSLOT, k = ph - layer * NSLOT, j = layer >> 1; const bool ssd = !(layer & 1);
    bf16_t* xb = (bf16_t*)(p.ws + WS_XB); float* ss = (float*)(p.ws + WS_SS);
    const int kk = k;
    EpiAll E{}; E.ss = ss; E.rsp = (const float*)(p.ws + WS_RS); E.scale = 1.0f;
    const bf16_t* A = xb; const bf16_t* Bt = nullptr; int N = 0, K = D_; bool gemm = true;
    switch (kk) {
    case 1: case 9: E.mode = 0; E.o0 = (bf16_t*)(p.ws + WS_R1); E.ld0 = FF_; Bt = (const bf16_t*)(p.ws + (kk == 1 ? WS_GU1 : WS_GU2)); N = 2 * FF_; break;
    case 2: case 10: E.mode = 1; E.o0 = xb; E.scale = 0.5f; A = (const bf16_t*)(p.ws + WS_R1); Bt = (const bf16_t*)(p.ws + (kk == 2 ? WS_D1 : WS_D2)); N = D_; K = FF_; break;
    case 3: E.mode = 2; Bt = (const bf16_t*)(p.ws + WS_MIN);
            if (ssd) { E.o0 = (bf16_t*)(p.ws + WS_R1); E.ld0 = DI_; E.nt0 = 8; E.o1 = (bf16_t*)(p.ws + WS_R2); E.ld1 = CONVD_; N = DI_ + CONVD_; }
            else { E.o0 = (bf16_t*)(p.ws + WS_R2); E.ld0 = CONVD_; E.nt0 = 12; E.o1 = E.o0; E.ld1 = CONVD_; N = CONVD_; } break;
    case 8: E.mode = 1; E.o0 = xb; A = (const bf16_t*)(p.ws + WS_R1); Bt = (const bf16_t*)(p.ws + WS_MOUT); N = D_; K = ssd ? DI_ : D_; break;
    default: gemm = false; break;
    }
    if (gemm) { run_gemm(lds, A, Bt, N, K, E, wv); if (kk == 3 && ssd) ssd_dt_phase(p, j, wv); return; }
    switch (kk) {
    case 0: prep_phase(p, layer, lds, wv); break;
    case 4: if (ssd) { ssd_conv_phase(p, j, wv); ssd_acs_phase(p, j, wv); } else sc_conv_phase(p, j, wv); break;
    case 5: if (ssd) ssd_states_phase(p, lds, wv); break;
    case 6: if (ssd) ssd_cscan_phase(p, wv); break;
    case 7: if (ssd) ssd_yout_phase(p, j, lds, wv); break;
    }
}

__global__ __launch_bounds__(512, 2) void mega(Params p) {
    extern __shared__ __attribute__((aligned(16))) unsigned char shm[];
    LAS unsigned char* lds = (LAS unsigned char*)shm;
    cg::grid_group grid = cg::this_grid();
    const int wv = __builtin_amdgcn_readfirstlane((int)(threadIdx.x >> 6));
    const bool t0 = (threadIdx.x == 0);
    if (threadIdx.x < 16) ((LAS unsigned*)(lds + LDS_CTL))[threadIdx.x] = 0u;
    __syncthreads();
    XcdBarrier xb = xcd_barrier_post((unsigned*)(p.ws + WS_BAR), (volatile LAS unsigned*)(lds + LDS_CTL), t0);
    bool first = true;
    for (int ph = p.ph_lo; ph < p.ph_hi; ++ph) {
        if (!phase_active(ph)) continue;
        { const int k = ph % NSLOT; if (ph < NPH - 1 && (k == 3 || k == 9)) { rs_phase(p, wv); xcd_barrier(xb, fresh_tid(wv) == 0); } }
        run_phase(p, ph, lds, wv);
        if (ph + 1 < p.ph_hi) {
            if (first) { __syncthreads(); grid.sync(); first = false; }
            else xcd_barrier(xb, fresh_tid(wv) == 0);
        }
    }
}

extern "C" void kernel_launch(void* const* d_in, const int* in_sizes, int n_in, void* d_out, int out_size, void* d_ws, size_t ws_size, hipStream_t stream) {
    static int grid = 0;
    if (grid == 0) {
        int dev = 0, cus = 0, per_cu = 0;
        hipGetDevice(&dev); hipDeviceGetAttribute(&cus, hipDeviceAttributeMultiprocessorCount, dev);
        hipFuncSetAttribute((const void*)mega, hipFuncAttributeMaxDynamicSharedMemorySize, LDS_BYTES);
        hipOccupancyMaxActiveBlocksPerMultiprocessor(&per_cu, (const void*)mega, 512, LDS_BYTES);
        if (per_cu < 1) per_cu = 1;
        grid = cus * per_cu;
        if (ws_size < WS_END) fprintf(stderr, "kernel_launch: workspace too small: %zu < %zu\n", ws_size, (size_t)WS_END);
        (void)hipGetLastError();
    }
    (void)hipMemsetAsync((unsigned char*)d_ws + WS_BAR, 0, 16384, stream);
    Params p{};
    p.x = (const float*)d_in[0]; p.norm_w = (const float*)d_in[1]; p.wg = (const float*)d_in[2]; p.wu = (const float*)d_in[3]; p.wd = (const float*)d_in[4];
    p.ssd_w_in = (const float*)d_in[5]; p.ssd_conv_w = (const float*)d_in[6]; p.ssd_conv_b = (const float*)d_in[7]; p.ssd_dt_bias = (const float*)d_in[8];
    p.ssd_a_log = (const float*)d_in[9]; p.ssd_d = (const float*)d_in[10]; p.ssd_norm_w = (const float*)d_in[11]; p.ssd_w_out = (const float*)d_in[12];
    p.sc_w_in = (const float*)d_in[13]; p.sc_conv_w = (const float*)d_in[14]; p.sc_w_out = (const float*)d_in[15]; p.final_w = (const float*)d_in[16];
    p.out = (float*)d_out; p.ws = (unsigned char*)d_ws;
#if ONE_LAUNCH
    p.ph_lo = 0; p.ph_hi = NPH;
    void* args[] = {&p};
    hipError_t e = hipLaunchCooperativeKernel((const void*)mega, dim3(grid), dim3(512), args, LDS_BYTES, stream);
    if (e != hipSuccess) fprintf(stderr, "cooperative launch failed: %s (grid %d)\n", hipGetErrorString(e), grid);
#else
    for (int ph = 0; ph < NPH; ++ph) { if (!phase_active(ph)) continue; p.ph_lo = ph; p.ph_hi = ph + 1; hipLaunchKernelGGL(mega, dim3(grid), dim3(512), LDS_BYTES, stream, p); }
#endif
}
```
